# Optimizing an MI355X kernel written in HIP

```python
import jax, jax.numpy as jnp
from jax import lax
import numpy as np


D_MODEL = 1024
BATCH = 8
SEQ = 4096
DEPTH = 2

HEAD_DIM = 64
N_HEADS_GDN = D_MODEL // 2 // HEAD_DIM
N_HEADS_RWKV = D_MODEL // 2 // HEAD_DIM
W_GDN = N_HEADS_GDN * HEAD_DIM
W_RWKV = N_HEADS_RWKV * HEAD_DIM
CONV_WIDTH = 4
GDN_CHUNK = 64
RWKV_DECAY_LORA = 64
RWKV_ICLR_LORA = 64
RWKV_GATE_LORA = 128
RWKV_GN_EPS = 64e-5
RWKV_IN = 3 * W_RWKV + RWKV_DECAY_LORA + RWKV_ICLR_LORA + RWKV_GATE_LORA
AB_IN = 4 * W_GDN + 2 * N_HEADS_GDN + RWKV_IN
AB_SPLITS = [3 * W_GDN, 4 * W_GDN, 4 * W_GDN + N_HEADS_GDN, 4 * W_GDN + 2 * N_HEADS_GDN]
RWKV_SPLITS = [W_RWKV, 2 * W_RWKV, 3 * W_RWKV, 3 * W_RWKV + RWKV_DECAY_LORA,
               3 * W_RWKV + RWKV_DECAY_LORA + RWKV_ICLR_LORA]
N_HEADS_RET = 8
RET_KEY_DIM = D_MODEL // N_HEADS_RET
RET_VAL_DIM = 2 * RET_KEY_DIM
W_RET_V = N_HEADS_RET * RET_VAL_DIM
RET_IN = 2 * D_MODEL + 2 * W_RET_V
RET_SPLITS = [D_MODEL, 2 * D_MODEL, 2 * D_MODEL + W_RET_V]
RET_CHUNK = 128
RET_GN_EPS = 1e-6
ROPE_BASE = 10000.0
D_FF = 4 * D_MODEL
RMS_EPS = 1e-6
N_EVEN = (DEPTH + 1) // 2
N_ODD = DEPTH // 2

kernel_name = "hybrid_gdn_rwkv7_retention_block"


def rmsnorm(x, w, eps=RMS_EPS):
    xf = x.astype(jnp.float32)
    return xf * lax.rsqrt(jnp.mean(xf * xf, axis=-1, keepdims=True) + eps) * w.astype(jnp.float32)


def l2norm(x, eps=1e-6):
    return x * lax.rsqrt(jnp.sum(x * x, axis=-1, keepdims=True) + eps)


def head_norm(y, eps):
    mean = jnp.mean(y, axis=-1, keepdims=True)
    var = jnp.mean(jnp.square(y - mean), axis=-1, keepdims=True)
    return (y - mean) * lax.rsqrt(var + eps)


def split_heads(x, n_heads):
    return x.reshape(*x.shape[:-1], n_heads, x.shape[-1] // n_heads)


def causal_depthwise_conv(x, w):
    K, C = w.shape
    return lax.conv_general_dilated(x, w[:, None, :].astype(x.dtype), window_strides=(1,),
                                    padding=[(K - 1, 0)], dimension_numbers=('NWC', 'WIO', 'NWC'),
                                    feature_group_count=C)


def gated_delta_rule(q, k, v, beta, g):
    Bsz, T, H, dk = q.shape
    dv = v.shape[-1]
    C = GDN_CHUNK
    N = T // C

    def chunks(a):
        a = jnp.moveaxis(a, 2, 1)
        return a.reshape(Bsz, H, N, C, *a.shape[3:])

    q, k, v, beta, g = (chunks(a) for a in (q * dk ** -0.5, k, v, beta, g))
    gcum = jnp.cumsum(g, axis=-1)
    causal = jnp.tril(jnp.ones((C, C), dtype=bool))
    strict = jnp.tril(jnp.ones((C, C), dtype=bool), -1)
    decay = jnp.exp(jnp.where(causal, gcum[..., :, None] - gcum[..., None, :], -jnp.inf))
    kb = k * beta[..., None]
    kkT = jnp.einsum('bhncd,bhnsd->bhncs', kb, k) * decay
    a_mat = jnp.where(strict, kkT, 0.0) + jnp.eye(C, dtype=kkT.dtype)
    rhs = jnp.concatenate([v * beta[..., None], kb * jnp.exp(gcum)[..., None]], axis=-1)
    sol = lax.linalg.triangular_solve(a_mat, rhs, left_side=True, lower=True, unit_diagonal=True)
    u, w = sol[..., :dv], sol[..., dv:]
    attn = jnp.einsum('bhncd,bhnsd->bhncs', q, k) * decay
    q_dec = q * jnp.exp(gcum)[..., None]
    k_dec = k * jnp.exp(gcum[..., -1:] - gcum)[..., None]
    blk_decay = jnp.exp(gcum[..., -1])

    def step(S, inp):
        u_c, w_c, attn_c, qd_c, kd_c, bd_c = inp
        v_new = u_c - jnp.einsum('bhck,bhkv->bhcv', w_c, S)
        o = jnp.einsum('bhck,bhkv->bhcv', qd_c, S) + jnp.einsum('bhcs,bhsv->bhcv', attn_c, v_new)
        S = S * bd_c[..., None, None] + jnp.einsum('bhck,bhcv->bhkv', kd_c, v_new)
        return S, o

    xs = tuple(jnp.moveaxis(a, 2, 0) for a in (u, w, attn, q_dec, k_dec, blk_decay))
    _, o = lax.scan(step, jnp.zeros((Bsz, H, dk, dv), jnp.float32), xs)
    o = jnp.moveaxis(o, 0, 2).reshape(Bsz, H, T, dv)
    return jnp.moveaxis(o, 1, 2)


def rwkv7_recurrence(r, w, k, v, kk, a):
    Bsz, T, H, d = r.shape

    def step(S, inp):
        r_t, w_t, k_t, v_t, kk_t, a_t = inp
        sa = jnp.einsum('bhvk,bhk->bhv', S, -kk_t)
        S = (S * w_t[:, :, None, :] + sa[..., None] * (kk_t * a_t)[:, :, None, :]
             + v_t[..., None] * k_t[:, :, None, :])
        return S, jnp.einsum('bhvk,bhk->bhv', S, r_t)

    xs = tuple(jnp.moveaxis(t, 1, 0) for t in (r, w, k, v, kk, a))
    _, y = lax.scan(step, jnp.zeros((Bsz, H, d, d), jnp.float32), xs)
    return jnp.moveaxis(y, 0, 1)


def hybrid_ab_mixer(u, w_in, conv_w, a_log, dt_bias, gdn_norm_w, mu, w0, w2, a0, a2, g2,
                    k_k, k_a, r_k, ln_w, ln_b, w_out):
    Bsz, T, _ = u.shape
    p = u @ w_in
    qkv, z, b_raw, alpha_raw, rp = jnp.split(p, AB_SPLITS, axis=-1)
    qkv = jax.nn.silu(causal_depthwise_conv(qkv, conv_w))
    q, k, v = (split_heads(t, N_HEADS_GDN) for t in jnp.split(qkv, 3, axis=-1))
    q, k = l2norm(q), l2norm(k)
    beta = jax.nn.sigmoid(b_raw)
    g = -jnp.exp(a_log.astype(jnp.float32)) * jax.nn.softplus(alpha_raw + dt_bias)
    o = gated_delta_rule(q, k, v, beta, g)
    o = rmsnorm(o, gdn_norm_w) * jax.nn.silu(split_heads(z, N_HEADS_GDN))
    o_a = o.reshape(Bsz, T, W_GDN)
    prev = jnp.pad(rp, ((0, 0), (1, 0), (0, 0)))[:, :-1]
    xs = rp + (prev - rp) * mu
    r, kr, vr, xw, xa, xg = jnp.split(xs, RWKV_SPLITS, axis=-1)
    w_log = -jax.nn.softplus(-(w0 + jnp.tanh(xw) @ w2)) - 0.5
    w_dec = jnp.exp(-jnp.exp(w_log))
    a = jax.nn.sigmoid(a0 + xa @ a2)
    gate = jax.nn.sigmoid(xg) @ g2
    kk = l2norm(split_heads(kr * k_k, N_HEADS_RWKV))
    kr = kr * (1.0 + (a - 1.0) * k_k * 0.0 + (a - 1.0) * k_a) if False else kr * (1.0 + (a - 1.0) * k_a)
    rh, kh, vh, ah, wh = (split_heads(t, N_HEADS_RWKV) for t in (r, kr, vr, a, w_dec))
    y = rwkv7_recurrence(rh, wh, kh, vh, kk, ah)
    y = head_norm(y, RWKV_GN_EPS).reshape(Bsz, T, W_RWKV) * ln_w + ln_b
    bonus = jnp.sum(rh * kh * r_k, axis=-1, keepdims=True) * vh
    o_b = (y + bonus.reshape(Bsz, T, W_RWKV)) * gate
    return jnp.concatenate([o_a, o_b], axis=-1) @ w_out


def rotary_every_two(x, pos):
    d = x.shape[-1]
    angle = 1.0 / (ROPE_BASE ** jnp.linspace(0.0, 1.0, d // 2, dtype=jnp.float32))
    theta = pos[:, None].astype(jnp.float32) * angle
    cos, sin = jnp.cos(theta)[:, None, :], jnp.sin(theta)[:, None, :]
    x1, x2 = x[..., 0::2], x[..., 1::2]
    return jnp.stack([x1 * cos - x2 * sin, x2 * cos + x1 * sin], axis=-1).reshape(x.shape)


def chunkwise_retention(q, k, v):
    Bsz, T, H, dk = q.shape
    dv = v.shape[-1]
    C = RET_CHUNK
    N = T // C
    log_gamma = jnp.log1p(-jnp.exp2(-5.0 - jnp.arange(H, dtype=jnp.float32)))

    def chunks(a):
        return jnp.moveaxis(a, 2, 1).reshape(Bsz, H, N, C, a.shape[-1])

    q, k, v = chunks(q), chunks(k), chunks(v)
    idx = jnp.arange(C, dtype=jnp.float32)
    rel = idx[:, None] - idx[None, :]
    intra = jnp.where(rel >= 0, jnp.exp(log_gamma[:, None, None] * jnp.maximum(rel, 0.0)), 0.0)
    scores = jnp.einsum('bhncd,bhnsd->bhncs', q, k) * intra[:, None]
    inner = jnp.einsum('bhncs,bhnsv->bhncv', scores, v)
    q_dec = q * jnp.exp(log_gamma[:, None] * (idx + 1.0))[:, None, :, None]
    k_dec = k * jnp.exp(log_gamma[:, None] * (C - 1.0 - idx))[:, None, :, None]
    blk = jnp.exp(log_gamma * C)[:, None, None]

    def step(S, inp):
        qd, kd, vc = inp
        o = jnp.einsum('bhck,bhkv->bhcv', qd, S)
        S = S * blk + jnp.einsum('bhck,bhcv->bhkv', kd, vc)
        return S, o

    xs = tuple(jnp.moveaxis(a, 2, 0) for a in (q_dec, k_dec, v))
    _, cross = lax.scan(step, jnp.zeros((Bsz, H, dk, dv), jnp.float32), xs)
    y = inner + jnp.moveaxis(cross, 0, 2)
    return jnp.moveaxis(y.reshape(Bsz, H, T, dv), 1, 2)


def retention_mixer(u, w_in, gn_w, w_out):
    Bsz, T, _ = u.shape
    q, k, v, g = jnp.split(u @ w_in, RET_SPLITS, axis=-1)
    pos = jnp.arange(T)
    q = rotary_every_two(split_heads(q, N_HEADS_RET), pos)
    k = rotary_every_two(split_heads(k, N_HEADS_RET), pos) * RET_KEY_DIM ** -0.5
    y = chunkwise_retention(q, k, split_heads(v, N_HEADS_RET))
    y = head_norm(y, RET_GN_EPS).reshape(Bsz, T, W_RET_V) * gn_w
    return (jax.nn.silu(g) * y) @ w_out


def setup_inputs(seed: int = 0) -> dict:
    key = jax.random.key(seed)
    ks = jax.random.split(key, 27)
    nrm = lambda k, shape, s: jax.random.normal(k, shape, jnp.float32) * s
    gain = lambda k, shape: 1.0 + 0.02 * jax.random.normal(k, shape, jnp.float32)
    col_scale = jnp.concatenate([jnp.ones((4 * W_GDN + N_HEADS_GDN,), jnp.float32),
                                 0.1 * jnp.ones((N_HEADS_GDN,), jnp.float32),
                                 jnp.ones((RWKV_IN,), jnp.float32)])
    dt = jnp.exp(jax.random.uniform(ks[9], (N_EVEN, N_HEADS_GDN), jnp.float32, np.log(1e-3), np.log(1e-1)))
    w0_base = -6.0 + 5.0 * jnp.linspace(0.0, 1.0, W_RWKV, dtype=jnp.float32) ** 0.85
    return {
        'x': nrm(ks[0], (BATCH, SEQ, D_MODEL), 1.0),
        'norm_mix_pre': gain(ks[1], (DEPTH, D_MODEL)),
        'norm_mix_post': gain(ks[2], (DEPTH, D_MODEL)),
        'norm_mlp_pre': gain(ks[3], (DEPTH, D_MODEL)),
        'norm_mlp_post': gain(ks[4], (DEPTH, D_MODEL)),
        'mlp_w_up': nrm(ks[5], (DEPTH, D_MODEL, D_FF), D_MODEL ** -0.5),
        'mlp_w_down': nrm(ks[6], (DEPTH, D_FF, D_MODEL), D_FF ** -0.5),
        'ab_w_in': nrm(ks[7], (N_EVEN, D_MODEL, AB_IN), D_MODEL ** -0.5) * col_scale,
        'gdn_conv_w': nrm(ks[8], (N_EVEN, CONV_WIDTH, 3 * W_GDN), CONV_WIDTH ** -0.5),
        'gdn_a_log': jnp.log(jax.random.uniform(ks[10], (N_EVEN, N_HEADS_GDN), jnp.float32, 1.0, 16.0)),
        'gdn_dt_bias': dt + jnp.log(-jnp.expm1(-dt)),
        'gdn_norm_w': gain(ks[11], (N_EVEN, HEAD_DIM)),
        'rwkv_mu': jax.random.uniform(ks[12], (N_EVEN, RWKV_IN), jnp.float32),
        'rwkv_w0': w0_base + 0.1 * jax.random.normal(ks[13], (N_EVEN, W_RWKV), jnp.float32),
        'rwkv_w2': nrm(ks[14], (N_EVEN, RWKV_DECAY_LORA, W_RWKV), 0.1 * RWKV_DECAY_LORA ** -0.5),
        'rwkv_a0': nrm(ks[15], (N_EVEN, W_RWKV), 0.1),
        'rwkv_a2': nrm(ks[16], (N_EVEN, RWKV_ICLR_LORA, W_RWKV), 0.1 * RWKV_ICLR_LORA ** -0.5),
        'rwkv_g2': nrm(ks[17], (N_EVEN, RWKV_GATE_LORA, W_RWKV), RWKV_GATE_LORA ** -0.5),
        'rwkv_k_k': 0.85 + 0.1 * jax.random.normal(ks[18], (N_EVEN, W_RWKV), jnp.float32),
        'rwkv_k_a': 1.0 + 0.1 * jax.random.normal(ks[19], (N_EVEN, W_RWKV), jnp.float32),
        'rwkv_r_k': nrm(ks[20], (N_EVEN, N_HEADS_RWKV, HEAD_DIM), 0.1),
        'rwkv_ln_w': gain(ks[21], (N_EVEN, W_RWKV)),
        'rwkv_ln_b': nrm(ks[22], (N_EVEN, W_RWKV), 0.02),
        'ab_w_out': nrm(ks[23], (N_EVEN, W_GDN + W_RWKV, D_MODEL), (W_GDN + W_RWKV) ** -0.5),
        'ret_w_in': nrm(ks[24], (N_ODD, D_MODEL, RET_IN), D_MODEL ** -0.5),
        'ret_gn_w': gain(ks[25], (N_ODD, W_RET_V)),
        'ret_w_out': nrm(ks[26], (N_ODD, W_RET_V, D_MODEL), W_RET_V ** -0.5),
    }


def reference(x, norm_mix_pre, norm_mix_post, norm_mlp_pre, norm_mlp_post, mlp_w_up, mlp_w_down,
              ab_w_in, gdn_conv_w, gdn_a_log, gdn_dt_bias, gdn_norm_w,
              rwkv_mu, rwkv_w0, rwkv_w2, rwkv_a0, rwkv_a2, rwkv_g2, rwkv_k_k, rwkv_k_a, rwkv_r_k,
              rwkv_ln_w, rwkv_ln_b, ab_w_out, ret_w_in, ret_gn_w, ret_w_out):
    h = x.astype(jnp.float32)
    for layer in range(DEPTH):
        j = layer // 2
        u = rmsnorm(h, norm_mix_pre[layer])
        if layer % 2 == 0:
            mix = hybrid_ab_mixer(u, ab_w_in[j], gdn_conv_w[j], gdn_a_log[j], gdn_dt_bias[j], gdn_norm_w[j],
                                  rwkv_mu[j], rwkv_w0[j], rwkv_w2[j], rwkv_a0[j], rwkv_a2[j], rwkv_g2[j],
                                  rwkv_k_k[j], rwkv_k_a[j], rwkv_r_k[j], rwkv_ln_w[j], rwkv_ln_b[j], ab_w_out[j])
        else:
            mix = retention_mixer(u, ret_w_in[j], ret_gn_w[j], ret_w_out[j])
        h = h + rmsnorm(mix, norm_mix_post[layer])
        u = rmsnorm(h, norm_mlp_pre[layer])
        f = jnp.square(jax.nn.relu(u @ mlp_w_up[layer])) @ mlp_w_down[layer]
        h = h + rmsnorm(f, norm_mlp_post[layer])
    return h.astype(x.dtype)
```

```cpp
#include <hip/hip_runtime.h>
#include <cstdio>
#include <cstdint>

#ifndef MK_PER_PHASE
#define MK_PER_PHASE 0
#endif

#define LAS __attribute__((address_space(3)))
typedef unsigned short bf16_t;
typedef short bf16x8 __attribute__((ext_vector_type(8)));
typedef short s16x4 __attribute__((ext_vector_type(4)));
typedef float f32x4 __attribute__((ext_vector_type(4)));
typedef float f32x2 __attribute__((ext_vector_type(2)));
typedef float f32x16 __attribute__((ext_vector_type(16)));
typedef unsigned u32x4 __attribute__((ext_vector_type(4)));
typedef unsigned u32x2 __attribute__((ext_vector_type(2)));
typedef __bf16 bf16x2_t __attribute__((ext_vector_type(2)));

#define DI __device__ __forceinline__

DI unsigned cvtpk(float lo, float hi) { f32x2 v = {lo, hi}; bf16x2_t b = __builtin_convertvector(v, bf16x2_t); return __builtin_bit_cast(unsigned, b); }
DI float bflo(unsigned w) { return __uint_as_float(w << 16); }
DI float bfhi(unsigned w) { return __uint_as_float(w & 0xffff0000u); }
DI float bf1(bf16_t h) { return __uint_as_float(((unsigned)h) << 16); }
DI void unpack8(const u32x4 w, float* f) { f[0] = bflo(w.x); f[1] = bfhi(w.x); f[2] = bflo(w.y); f[3] = bfhi(w.y); f[4] = bflo(w.z); f[5] = bfhi(w.z); f[6] = bflo(w.w); f[7] = bfhi(w.w); }
DI u32x4 pack8(const float* f) { u32x4 w; w.x = cvtpk(f[0], f[1]); w.y = cvtpk(f[2], f[3]); w.z = cvtpk(f[4], f[5]); w.w = cvtpk(f[6], f[7]); return w; }
DI float sigmoidf_(float x) { return __builtin_amdgcn_rcpf(1.0f + __expf(-x)); }
DI float siluf_(float x) { return x * __builtin_amdgcn_rcpf(1.0f + __expf(-x)); }
DI float softplusf_(float x) { return fmaxf(x, 0.f) + __logf(1.0f + __expf(-fabsf(x))); }

constexpr int BATCH = 8, SEQ = 4096, DM = 1024, MTOK = BATCH * SEQ;
constexpr int FF = 4096;
constexpr int AB_IN = 3856, AB_PAD = 4096;
constexpr int RP0 = 2064;
constexpr int RET_IN = 6144;
constexpr float RMS_EPS = 1e-6f;

namespace pg8 {
constexpr int BM = 256, BK = 64, HALF = 128, HTB = HALF * BK * 2, STAGE_BYTES = 8 * HTB, NXCD = 8, WGM = 8;
__host__ __device__ __forceinline__ int lds_byte(int r, int c) { const int st = (r >> 4) * 2 + (c >> 5), rr = r & 15, cc = c & 31, ob = rr * 64 + cc * 2; return st * 1024 + (ob ^ (((ob >> 9) & 1) << 5)); }
__host__ __device__ __forceinline__ void stage_rc(int b, int& R, int& C) { const int st = b / 1024, sb = b % 1024, swz = sb ^ (((sb >> 9) & 1) << 5); R = (st >> 1) * 16 + swz / 64; C = (st & 1) * 32 + (swz % 64) / 2; }
__host__ __device__ __forceinline__ int perm32(int rho) { const int n = rho >> 4, i = rho & 15; return 8 * (i >> 2) + 4 * n + (i & 3); }
struct Unit { int pm, pn; };
struct Gemm { const bf16_t* A; const bf16_t* Bt; int M, N, K, lda; };
struct StaticOrder {
    int nM, nN, nwg, G, c;
    __device__ void init(int M, int N, int G_, int c_) { nM = M / BM; nN = N / BM; nwg = nM * nN; G = G_; c = c_; }
    __device__ bool next(int i, Unit& u) const {
        const long L = (long)i * G + c; if (L >= nwg) return false;
        int wgid = (int)L; { const int q = nwg / NXCD, r = nwg % NXCD, xcd = wgid % NXCD, off = wgid / NXCD; wgid = (xcd < r ? xcd * (q + 1) : r * (q + 1) + (xcd - r) * q) + off; }
        const int nig = WGM * nN, gid = wgid / nig, fm = gid * WGM, gsz = (nM - fm) < WGM ? (nM - fm) : WGM;
        u.pm = fm + ((wgid % nig) % gsz); u.pn = (wgid % nig) / gsz; return true;
    }
};
template <class F> struct Epi {
    F f;
    __device__ __forceinline__ void operator()(const f32x4 (&acc)[2][2][4][2], const Unit& u, int wr, int wc, int fr, int fq) const {
        const int row0 = u.pm * BM + wr * 64 + fr, col0 = u.pn * BM + wc * 32 + 8 * fq;
        typename F::Pre pre; f.prepare(pre, row0, col0);
#pragma unroll
        for (int ai = 0; ai < 2; ++ai) {
            f.batch(pre, row0 + ai * HALF, col0);
            __builtin_amdgcn_sched_barrier(0);
#pragma unroll
            for (int m = 0; m < 4; ++m)
#pragma unroll
                for (int bj = 0; bj < 2; ++bj) {
                    const f32x4 v0 = acc[ai][bj][m][0], v1 = acc[ai][bj][m][1];
                    float v[8] = {v0[0], v0[1], v0[2], v0[3], v1[0], v1[1], v1[2], v1[3]};
                    f(row0 + ai * HALF + m * 16, col0 + bj * HALF, v, ai * 4 + m, m, bj, pre);
                }
        }
    }
};

typedef int i32x4 __attribute__((ext_vector_type(4)));
template <bool I8> __device__ __forceinline__ f32x4 mma16(const bf16x8 b, const bf16x8 a, const f32x4 c) {
    if constexpr (I8) return __builtin_bit_cast(f32x4, __builtin_amdgcn_mfma_i32_16x16x64_i8(__builtin_bit_cast(i32x4, b), __builtin_bit_cast(i32x4, a), __builtin_bit_cast(i32x4, c), 0, 0, 0));
    else return __builtin_amdgcn_mfma_f32_16x16x32_bf16(b, a, c, 0, 0, 0);
}
template <bool I8, class EpiT>
__device__ __forceinline__ void gemm_phase(LAS unsigned char* lds, int wid, const Gemm g, const StaticOrder& S, const EpiT& E) {
    const int lane = (int)__builtin_amdgcn_mbcnt_hi(~0u, __builtin_amdgcn_mbcnt_lo(~0u, 0u)), tid = wid * 64 + lane, wr = wid >> 2, wc = wid & 3, fr = lane & 15, fq = lane >> 4;
    const int K = g.K, nt = K / BK, lda = g.lda;
    unsigned voffA[2], voffB[2];
#pragma unroll
    for (int i = 0; i < 2; ++i) { int R, C; stage_rc(tid * 16 + i * 8192, R, C); const int Rb = (R & ~31) + perm32(R & 31);
        voffA[i] = (unsigned)(R * lda + C) * 2u; voffB[i] = (unsigned)(Rb * K + C) * 2u; }
    const size_t kstep = (size_t)(BK * 2);
    const size_t hstepA = (size_t)HALF * lda * 2, hstepB = (size_t)HALF * K * 2;
    const size_t tstepA = 2 * hstepA, tstepB = 2 * hstepB;
    const unsigned ldsw = (unsigned)wid * 1024u;
    const int aoff = lds_byte(wr * 64 + fr, fq * 8), boff = lds_byte(wc * 32 + fr, fq * 8);
#define PG8_SA(b, h) (((b) * 2 + (h)) * HTB)
#define PG8_SB(b, h) ((4 + (b) * 2 + (h)) * HTB)
#define PG8_STAGE(bufoff, gbase, voff) do { _Pragma("unroll") for (int _i = 0; _i < 2; ++_i) \
        __builtin_amdgcn_global_load_lds((const unsigned*)((const char*)(gbase) + (voff)[_i]), (LAS unsigned*)(lds + (bufoff) + ldsw + _i * 8192), 16, 0, 0); } while (0)
#define PG8_LDA(dst, b, h) do { _Pragma("unroll") for (int m = 0; m < 4; ++m) _Pragma("unroll") for (int k = 0; k < 2; ++k) dst[m][k] = *(const LAS bf16x8*)(lds + PG8_SA(b, h) + aoff + m * 2048 + k * 1024); } while (0)
#define PG8_LDB(dst, b, h) do { _Pragma("unroll") for (int n = 0; n < 2; ++n) _Pragma("unroll") for (int k = 0; k < 2; ++k) dst[n][k] = *(const LAS bf16x8*)(lds + PG8_SB(b, h) + boff + n * 2048 + k * 1024); } while (0)
#define PG8_MMA(ai, bj, At, Bt) do { __builtin_amdgcn_s_setprio(1); _Pragma("unroll") for (int m = 0; m < 4; ++m) _Pragma("unroll") for (int n = 0; n < 2; ++n) _Pragma("unroll") for (int k = 0; k < 2; ++k) \
        acc[ai][bj][m][n] = mma16<I8>(Bt[n][k], At[m][k], acc[ai][bj][m][n]); __builtin_amdgcn_s_setprio(0); } while (0)
#define PG8_WAIT_V(n) asm volatile("s_waitcnt vmcnt(" #n ")" ::: "memory")
#define PG8_WAIT_L(n) asm volatile("s_waitcnt lgkmcnt(" #n ")" ::: "memory")
#define PG8_BAR __builtin_amdgcn_s_barrier()
#define PG8_SCHED __builtin_amdgcn_sched_barrier(0)
    Unit cur, nxt; int ui = 0;
    if (!S.next(0, cur)) return;
    f32x4 acc[2][2][4][2];
#pragma unroll
    for (int a = 0; a < 2; ++a)
#pragma unroll
        for (int b = 0; b < 2; ++b)
#pragma unroll
            for (int m = 0; m < 4; ++m)
#pragma unroll
                for (int n = 0; n < 2; ++n) acc[a][b][m][n] = (f32x4){0.f, 0.f, 0.f, 0.f};
    bf16x8 At[4][2], B0[2][2], B1[2][2];
    const char* cA = (const char*)g.A + (size_t)cur.pm * tstepA; const char* cB = (const char*)g.Bt + (size_t)cur.pn * tstepB;
    PG8_STAGE(PG8_SB(0, 0), cB, voffB); PG8_STAGE(PG8_SB(0, 1), cB + hstepB, voffB); PG8_STAGE(PG8_SA(0, 0), cA, voffA); PG8_STAGE(PG8_SA(0, 1), cA + hstepA, voffA);
    if (wr == 1) PG8_BAR;
    PG8_WAIT_V(2); PG8_BAR;
    PG8_STAGE(PG8_SB(1, 0), cB + kstep, voffB); PG8_STAGE(PG8_SA(1, 0), cA + kstep, voffA); PG8_STAGE(PG8_SB(1, 1), cB + hstepB + kstep, voffB);
    PG8_WAIT_V(6); PG8_BAR;
    for (;;) {
        const bool has_next = S.next(ui + 1, nxt);
        const char* nA = has_next ? (const char*)g.A + (size_t)nxt.pm * tstepA : cA; const char* nB = has_next ? (const char*)g.Bt + (size_t)nxt.pn * tstepB : cB;
        for (int t = 0; t < nt; t += 2) {
            const bool last = (t == nt - 2);
            const char* a1 = cA + (size_t)(t + 1) * kstep;
            const char* a2 = last ? nA : cA + (size_t)(t + 2) * kstep; const char* b2 = last ? nB : cB + (size_t)(t + 2) * kstep;
            const char* a3 = a2 + kstep; const char* b3 = b2 + kstep;
            PG8_LDB(B0, 0, 0); PG8_LDB(B1, 0, 1); PG8_SCHED; PG8_LDA(At, 0, 0); PG8_STAGE(PG8_SA(1, 1), a1 + hstepA, voffA);
            PG8_WAIT_V(8); PG8_WAIT_L(0); PG8_BAR; PG8_MMA(0, 0, At, B0); PG8_MMA(0, 1, At, B1); PG8_BAR; PG8_SCHED;
            PG8_LDA(At, 0, 1); PG8_STAGE(PG8_SB(0, 0), b2, voffB); PG8_STAGE(PG8_SB(0, 1), b2 + hstepB, voffB); PG8_STAGE(PG8_SA(0, 0), a2, voffA);
            PG8_WAIT_V(8); PG8_WAIT_L(0); PG8_BAR; PG8_MMA(1, 0, At, B0); PG8_MMA(1, 1, At, B1); PG8_BAR; PG8_SCHED;
            PG8_LDB(B0, 1, 0); PG8_LDB(B1, 1, 1); PG8_SCHED; PG8_LDA(At, 1, 0); PG8_STAGE(PG8_SA(0, 1), a2 + hstepA, voffA);
            PG8_WAIT_V(8); PG8_WAIT_L(0); PG8_BAR; PG8_MMA(0, 0, At, B0); PG8_MMA(0, 1, At, B1); PG8_BAR; PG8_SCHED;
            PG8_LDA(At, 1, 1); PG8_STAGE(PG8_SB(1, 0), b3, voffB); PG8_STAGE(PG8_SB(1, 1), b3 + hstepB, voffB); PG8_STAGE(PG8_SA(1, 0), a3, voffA);
            PG8_WAIT_V(8); PG8_WAIT_L(0); PG8_BAR; PG8_MMA(1, 0, At, B0); PG8_MMA(1, 1, At, B1); PG8_BAR; PG8_SCHED;
        }
        if (wr == 0) PG8_BAR;
        if constexpr (I8) {
#pragma unroll
            for (int a = 0; a < 2; ++a)
#pragma unroll
                for (int b = 0; b < 2; ++b)
#pragma unroll
                    for (int m = 0; m < 4; ++m)
#pragma unroll
                        for (int n = 0; n < 2; ++n) { const i32x4 iv = __builtin_bit_cast(i32x4, acc[a][b][m][n]); acc[a][b][m][n] = (f32x4){(float)iv[0], (float)iv[1], (float)iv[2], (float)iv[3]}; }
        }
        E(acc, cur, wr, wc, fr, fq);
        if (!has_next) break;
#pragma unroll
        for (int a = 0; a < 2; ++a)
#pragma unroll
            for (int b = 0; b < 2; ++b)
#pragma unroll
                for (int m = 0; m < 4; ++m)
#pragma unroll
                    for (int n = 0; n < 2; ++n) acc[a][b][m][n] = (f32x4){0.f, 0.f, 0.f, 0.f};
        cur = nxt; cA = nA; cB = nB; ++ui;
        if (wr == 1) PG8_BAR;
    }
    PG8_WAIT_V(0);
    PG8_BAR;
#undef PG8_SA
#undef PG8_SB
#undef PG8_STAGE
#undef PG8_LDA
#undef PG8_LDB
#undef PG8_MMA
#undef PG8_WAIT_V
#undef PG8_WAIT_L
#undef PG8_BAR
#undef PG8_SCHED
}
}

struct PreNone {};
struct FStore { bf16_t* O; int ldc; typedef PreNone Pre;
    DI void prepare(Pre&, int, int) const {} DI void batch(Pre&, int, int) const {}
    DI void operator()(int row, int col, const float* v, int, int, int, const Pre&) const { *(u32x4*)(O + (size_t)row * ldc + col) = pack8(v); } };
struct PreRs { float rs[8]; };
struct FStoreRs { bf16_t* O; int ldc; const float* rs; typedef PreRs Pre;
    DI void prepare(Pre& p, int row0, int) const {
#pragma unroll
        for (int q = 0; q < 8; ++q) p.rs[q] = rs[row0 + (q >> 2) * 128 + (q & 3) * 16]; }
    DI void batch(Pre&, int, int) const {}
    DI void operator()(int row, int col, const float* v, int ri, int, int, const Pre& p) const { const float s = p.rs[ri]; float w[8];
#pragma unroll
        for (int e = 0; e < 8; ++e) w[e] = v[e] * s;
        *(u32x4*)(O + (size_t)row * ldc + col) = pack8(w); } };
struct PreRsSw { float rs[8]; f32x4 sw[2][2]; };
struct FRelu2 { bf16_t* O; int ldc; const float* rs; const float* sw; typedef PreRsSw Pre;
    DI void prepare(Pre& p, int row0, int col0) const {
#pragma unroll
        for (int q = 0; q < 8; ++q) p.rs[q] = rs[row0 + (q >> 2) * 128 + (q & 3) * 16];
#pragma unroll
        for (int bj = 0; bj < 2; ++bj) { if (sw) { p.sw[bj][0] = *(const f32x4*)(sw + col0 + bj * 128); p.sw[bj][1] = *(const f32x4*)(sw + col0 + bj * 128 + 4); } else { p.sw[bj][0] = (f32x4){1.f, 1.f, 1.f, 1.f}; p.sw[bj][1] = (f32x4){1.f, 1.f, 1.f, 1.f}; } } }
    DI void batch(Pre&, int, int) const {}
    DI void operator()(int row, int col, const float* v, int ri, int, int bj, const Pre& p) const { float w[8]; const float s = p.rs[ri];
        const float cs8[8] = {p.sw[bj][0].x, p.sw[bj][0].y, p.sw[bj][0].z, p.sw[bj][0].w, p.sw[bj][1].x, p.sw[bj][1].y, p.sw[bj][1].z, p.sw[bj][1].w};
#pragma unroll
        for (int e = 0; e < 8; ++e) { const float r = fmaxf(v[e] * s * cs8[e], 0.f); w[e] = r * r; }
        *(u32x4*)(O + (size_t)row * ldc + col) = pack8(w); } };
struct PreRot { float rs[8]; f32x4 sw[2][2]; f32x2 rot[4][4]; };
constexpr size_t P1_Q = 0, P1_K = (size_t)32768 * 1024, P1_V = 2 * P1_K, P1_G = P1_V + (size_t)32768 * 2048;
struct FRotary { bf16_t* O; const f32x2* rot; const float* rs; const float* sw; typedef PreRot Pre;
    DI void prepare(Pre& p, int row0, int col0) const {
#pragma unroll
        for (int q = 0; q < 8; ++q) p.rs[q] = rs[row0 + (q >> 2) * 128 + (q & 3) * 16];
#pragma unroll
        for (int bj = 0; bj < 2; ++bj) { p.sw[bj][0] = *(const f32x4*)(sw + col0 + bj * 128); p.sw[bj][1] = *(const f32x4*)(sw + col0 + bj * 128 + 4); } }
    DI void batch(Pre& p, int rowb, int col0) const {
        if (col0 < 2048) { const int i0 = (col0 & 127) >> 1;
#pragma unroll
            for (int m = 0; m < 4; ++m) { const int pos = (rowb + m * 16) & (SEQ - 1);
#pragma unroll
                for (int q = 0; q < 4; ++q) p.rot[m][q] = rot[pos * 64 + i0 + q]; } } }
    DI void operator()(int row, int col, const float* v0, int ri, int m, int bj, const Pre& p) const { float w[8], v[8]; const float s = p.rs[ri];
        const float cs8[8] = {p.sw[bj][0].x, p.sw[bj][0].y, p.sw[bj][0].z, p.sw[bj][0].w, p.sw[bj][1].x, p.sw[bj][1].y, p.sw[bj][1].z, p.sw[bj][1].w};
#pragma unroll
        for (int e = 0; e < 8; ++e) v[e] = v0[e] * s * cs8[e];
        if (col < 2048) { const float sc = (col >= 1024) ? 0.08838834764831845f : 1.0f;
#pragma unroll
            for (int q = 0; q < 4; ++q) { const f32x2 cs = p.rot[m][q]; const float x1 = v[2 * q], x2 = v[2 * q + 1];
                w[2 * q] = (x1 * cs.x - x2 * cs.y) * sc; w[2 * q + 1] = (x2 * cs.x + x1 * cs.y) * sc; }
        } else {
#pragma unroll
            for (int e = 0; e < 8; ++e) w[e] = v[e];
        }
        const int bb = row >> 12, t = row & 4095; size_t d;
        if (col < 2048) { const int c = col & 1023; d = (col < 1024 ? P1_Q : P1_K) + ((size_t)(bb * 8 + (c >> 7)) * 4096 + t) * 128 + (c & 127); }
        else if (col < 4096) { const int c = col - 2048; d = P1_V + ((size_t)(bb * 8 + (c >> 8)) * 4096 + t) * 256 + (c & 255); }
        else d = P1_G + (size_t)row * 2048 + (col - 4096);
        *(u32x4*)(O + d) = pack8(w); } };
struct PreLora { f32x4 b[2][2]; };
struct FLora { bf16_t* LW; bf16_t* AA; bf16_t* GT; const float* w0; const float* a0; typedef PreLora Pre;
    DI void prepare(Pre& p, int, int col0) const {
#pragma unroll
        for (int bj = 0; bj < 2; ++bj) { const int col = col0 + bj * 128; const float* src = col < 512 ? w0 + col : (col < 1024 ? a0 + (col - 512) : nullptr);
            if (src) { p.b[bj][0] = *(const f32x4*)src; p.b[bj][1] = *(const f32x4*)(src + 4); } else { p.b[bj][0] = (f32x4){0.f, 0.f, 0.f, 0.f}; p.b[bj][1] = (f32x4){0.f, 0.f, 0.f, 0.f}; } } }
    DI void batch(Pre&, int, int) const {}
    DI void operator()(int row, int col, const float* v, int, int, int bj, const Pre& p) const { float w[8]; bf16_t* dst;
        const float b8[8] = {p.b[bj][0].x, p.b[bj][0].y, p.b[bj][0].z, p.b[bj][0].w, p.b[bj][1].x, p.b[bj][1].y, p.b[bj][1].z, p.b[bj][1].w};
        if (col < 512) { dst = LW + (size_t)row * 512 + col;
#pragma unroll
            for (int e = 0; e < 8; ++e) { const float x = v[e] + b8[e]; const float wl = -softplusf_(-x) - 0.5f; w[e] = -__expf(wl); }
        } else if (col < 1024) { dst = AA + (size_t)row * 512 + (col - 512);
#pragma unroll
            for (int e = 0; e < 8; ++e) w[e] = sigmoidf_(v[e] + b8[e]);
        } else { dst = GT + (size_t)row * 512 + (col - 1024);
#pragma unroll
            for (int e = 0; e < 8; ++e) w[e] = v[e];
        }
        *(u32x4*)dst = pack8(w); } };

constexpr size_t MiB = 1u << 20;
constexpr size_t WS_CTL = 0, CTL_ZERO_BYTES = 192 * 1024;
constexpr size_t WS_CMAX = 64 * 1024;
constexpr size_t WS_SW = 256 * 1024;
constexpr size_t WS_RS = 512 * 1024;
constexpr size_t WS_HB = 448 * MiB;
constexpr size_t WS_ROT = 1 * MiB;
constexpr size_t WS_W = 3 * MiB;
constexpr size_t W_IN0 = WS_W, W_OUT0 = W_IN0 + 8 * MiB, W_UP0 = W_OUT0 + 2 * MiB, W_DN0 = W_UP0 + 8 * MiB, W_IN1 = W_DN0 + 8 * MiB, W_OUT1 = W_IN1 + 12 * MiB,
                 W_UP1 = W_OUT1 + 4 * MiB, W_DN1 = W_UP1 + 8 * MiB, W_LORA = W_DN1 + 8 * MiB;
constexpr size_t R_U = 64 * MiB, R_A = 128 * MiB, R_B = 384 * MiB, WS_END = 512 * MiB;
constexpr size_t WS_LW = R_B, WS_AA = R_B + 32 * MiB, WS_GT = R_B + 64 * MiB, WS_AP = R_B + 96 * MiB;
static_assert(W_LORA + 1536 * 256 * 2 <= R_U, "weights fit below R_U");

constexpr int RING_BYTES = 131072, MISC_OFF = RING_BYTES + 320, LDS_BYTES = 147456;

#define XB_TMO      128
#define XB_XCNT(j)  (256  + 64 * (j))
#define XB_XSUB(j)  (1280 + 64 * (j))
#define XB_XGEN(j)  (2304 + 64 * (j))
#define XB_TOP      3328
#define XB_TOPGEN   3392
#define XCD_BAR_WORDS 3456
#define XB_SPIN_CAP (1u << 22)
DI unsigned xb_ld(unsigned* p)              { return __hip_atomic_load(p, __ATOMIC_RELAXED, __HIP_MEMORY_SCOPE_AGENT); }
DI unsigned xb_add(unsigned* p, unsigned v) { return __hip_atomic_fetch_add(p, v, __ATOMIC_RELAXED, __HIP_MEMORY_SCOPE_AGENT); }
DI unsigned xb_poll(unsigned* p)            { unsigned r; const unsigned z = 0u; asm volatile("global_atomic_add %0, %1, %2, off sc0\n\ts_waitcnt vmcnt(0)" : "=v"(r) : "v"(p), "v"(z) : "memory"); return r; }
DI unsigned xb_xcc_id() { return (unsigned)__builtin_amdgcn_s_getreg((3 << 11) | 20) & 0xFu; }
#define XB_SPIN(cond, bar) do { unsigned _sp = 0; while (cond) { __builtin_amdgcn_s_sleep(1); \
    if ((++_sp & 255u) == 0u) { if (xb_ld(&(bar)[XB_TMO])) break; if (_sp > XB_SPIN_CAP) { atomicAdd(&(bar)[XB_TMO], 1u); break; } } } } while (0)
struct XcdBarrier { unsigned* bar; unsigned x; volatile LAS unsigned* st; };
DI XcdBarrier xcd_barrier_post(unsigned* bar, volatile LAS unsigned* st) {
    XcdBarrier b; b.bar = bar; b.x = xb_xcc_id(); b.st = st;
    if (threadIdx.x == 0) (void)xb_add(&bar[XB_XCNT(b.x)], 1u);
    return b;
}
DI void xcd_barrier_complete(unsigned* bar, unsigned x, unsigned& nloc, unsigned& nx) {
    const unsigned G = gridDim.x * gridDim.y * gridDim.z;
    unsigned sum, cnt, mine, sp = 0u;
    for (;;) {
        sum = 0u; cnt = 0u; mine = 0u;
#pragma unroll
        for (unsigned j = 0; j < 16; ++j) { const unsigned c = xb_ld(&bar[XB_XCNT(j)]); sum += c; cnt += (c > 0u) ? 1u : 0u; mine = (j == x) ? c : mine; }
        if (sum == G) break;
        __builtin_amdgcn_s_sleep(1);
        if ((++sp & 255u) == 0u) { if (xb_ld(&bar[XB_TMO])) break; if (sp > XB_SPIN_CAP) { atomicAdd(&bar[XB_TMO], 1u); break; } }
    }
    nloc = mine > 0u ? mine : 1u; nx = cnt > 0u ? cnt : 1u;
}
DI void xcd_barrier(const XcdBarrier& b) {
    asm volatile("s_waitcnt vmcnt(0)" ::: "memory");
    __syncthreads();
    if (threadIdx.x == 0) {
        unsigned* bar = b.bar;
        __builtin_amdgcn_s_waitcnt(0);
        unsigned nloc = b.st[0], nx = b.st[1];
        if (nloc == 0u) { xcd_barrier_complete(bar, b.x, nloc, nx); b.st[0] = nloc; b.st[1] = nx; }
        const unsigned old = xb_add(&bar[XB_XSUB(b.x)], 1u);
        const unsigned gen = old / nloc;
        if (old + 1u == (gen + 1u) * nloc) {
            __builtin_amdgcn_fence(__ATOMIC_RELEASE, "agent");
            asm volatile("s_waitcnt vmcnt(0)" ::: "memory");
            const unsigned og = xb_add(&bar[XB_TOP], 1u);
            const unsigned tg = og / nx;
            if (og + 1u == (tg + 1u) * nx) xb_add(&bar[XB_TOPGEN], 1u);
            else XB_SPIN(xb_poll(&bar[XB_TOPGEN]) == tg, bar);
            __builtin_amdgcn_fence(__ATOMIC_ACQUIRE, "agent");
            xb_add(&bar[XB_XGEN(b.x)], 1u);
            asm volatile("s_waitcnt vmcnt(0)" ::: "memory");
        } else {
            XB_SPIN(xb_poll(&bar[XB_XGEN(b.x)]) == gen, bar);
            __builtin_amdgcn_fence(__ATOMIC_ACQUIRE, "agent");
            asm volatile("s_waitcnt vmcnt(0)" ::: "memory");
        }
    }
    __syncthreads();
}

template <int CTRL> DI float dppmov(float x) { return __int_as_float(__builtin_amdgcn_update_dpp(0, __float_as_int(x), CTRL, 0xF, 0xF, true)); }
DI float red8(float x) { x += dppmov<0xB1>(x); x += dppmov<0x4E>(x); x += dppmov<0x141>(x); return x; }
DI float red16(float x) { x = red8(x); x += dppmov<0x140>(x); return x; }
DI float red16max(float x) { x = fmaxf(x, dppmov<0xB1>(x)); x = fmaxf(x, dppmov<0x4E>(x)); x = fmaxf(x, dppmov<0x141>(x)); x = fmaxf(x, dppmov<0x140>(x)); return x; }
DI float rlane(float x, int l) { return __int_as_float(__builtin_amdgcn_readlane(__float_as_int(x), l)); }
DI float wave_sum(float v) { v = red16(v); return (rlane(v, 0) + rlane(v, 16)) + (rlane(v, 32) + rlane(v, 48)); }
DI float wave_max(float v) { v = red16max(v); return fmaxf(fmaxf(rlane(v, 0), rlane(v, 16)), fmaxf(rlane(v, 32), rlane(v, 48))); }

DI int lane_id() { int l; asm volatile("v_mbcnt_lo_u32_b32 %0, -1, 0\n\tv_mbcnt_hi_u32_b32 %0, -1, %0" : "=v"(l)); return l; }
struct Ctx { LAS unsigned char* lds; int wave, vcu, G; };

struct TrRegs { f32x4 v[8]; float sc[8]; f32x4 cs; };
DI void tr_issue(TrRegs& L, const float* W, const float* ksc, const unsigned* cmax, int Nsrc, int Npad, int item, int lane) {
    const int nblk = Npad / 32, kb = item / nblk, nb = item % nblk, k0 = 64 * kb, n = 32 * nb + 4 * (lane & 7), rr = lane >> 3; const bool ok = n < Nsrc;
#pragma unroll
    for (int i = 0; i < 8; ++i) { const int k = k0 + 8 * i + rr; L.v[i] = (f32x4){0.f, 0.f, 0.f, 0.f}; if (ok) L.v[i] = *(const f32x4*)(W + (size_t)k * Nsrc + n); L.sc[i] = ksc ? ksc[k] : 1.0f; }
    if (cmax) { const u32x4 m = *(const u32x4*)(cmax + n);
        L.cs = (f32x4){127.0f / fmaxf(__uint_as_float(m.x), 1e-30f), 127.0f / fmaxf(__uint_as_float(m.y), 1e-30f), 127.0f / fmaxf(__uint_as_float(m.z), 1e-30f), 127.0f / fmaxf(__uint_as_float(m.w), 1e-30f)}; }
}
DI void tr_to_lds(const TrRegs& L, bool q, LAS float* scr, int lane) {
    const int rr = lane >> 3, c4 = 4 * (lane & 7);
#pragma unroll
    for (int i = 0; i < 8; ++i) { f32x4 x = L.v[i] * L.sc[i]; if (q) x = x * L.cs; LAS float* d = scr + (8 * i + rr) * 33 + c4; d[0] = x.x; d[1] = x.y; d[2] = x.z; d[3] = x.w; }
    asm volatile("s_waitcnt lgkmcnt(0)" ::: "memory");
}
DI void tr_store(int K, int Npad, bf16_t* WT, const LAS float* scr, int item, int lane) {
    const int nblk = Npad / 32, kb = item / nblk, nb = item % nblk, k0 = 64 * kb, n0 = 32 * nb, c = lane >> 3;
#pragma unroll
    for (int j = 0; j < 4; ++j) { const int nn = (lane & 7) + 8 * j; const LAS float* p = scr + (8 * c) * 33 + nn;
        u32x4 o; o.x = cvtpk(p[0 * 33], p[1 * 33]); o.y = cvtpk(p[2 * 33], p[3 * 33]); o.z = cvtpk(p[4 * 33], p[5 * 33]); o.w = cvtpk(p[6 * 33], p[7 * 33]);
        *(u32x4*)(WT + (size_t)(n0 + nn) * K + k0 + 8 * c) = o; }
    asm volatile("s_waitcnt lgkmcnt(0)" ::: "memory");
}
DI void tr_store_q(int K, int Npad, signed char* WT, const LAS float* scr, int item, int lane) {
    const int nblk = Npad / 32, kb = item / nblk, nb = item % nblk, k0 = 64 * kb, n0 = 32 * nb, c = lane >> 4;
#pragma unroll
    for (int j = 0; j < 2; ++j) { const int nn = (lane & 15) + 16 * j; const LAS float* sp = scr + (16 * c) * 33 + nn; unsigned o[4];
#pragma unroll
        for (int q = 0; q < 4; ++q) { unsigned wv = 0;
#pragma unroll
            for (int e = 0; e < 4; ++e) { const int iv = (int)rintf(sp[(4 * q + e) * 33]); wv |= ((unsigned)iv & 0xffu) << (8 * e); }
            o[q] = wv; }
        *(u32x4*)(WT + (size_t)(n0 + nn) * K + k0 + 16 * c) = (u32x4){o[0], o[1], o[2], o[3]}; }
    asm volatile("s_waitcnt lgkmcnt(0)" ::: "memory");
}
DI void rows2_to_bf16_rs(const float* x, bf16_t* o, float* rsout, int m0, int m1, int lane) {
    const int mm[2] = {m0, m1}; f32x4 v[2][4];
#pragma unroll
    for (int r = 0; r < 2; ++r) { const f32x4* xr = (const f32x4*)(x + (size_t)mm[r] * DM) + lane;
#pragma unroll
        for (int j = 0; j < 4; ++j) v[r][j] = __builtin_nontemporal_load(xr + 64 * j); }
#pragma unroll
    for (int r = 0; r < 2; ++r) { float s = 0.f;
#pragma unroll
        for (int j = 0; j < 4; ++j) s += (v[r][j].x * v[r][j].x + v[r][j].y * v[r][j].y) + (v[r][j].z * v[r][j].z + v[r][j].w * v[r][j].w);
        const float rs = __builtin_amdgcn_rsqf(wave_sum(s) * (1.f / DM) + RMS_EPS);
        u32x2* o8 = (u32x2*)(o + (size_t)mm[r] * DM) + lane;
#pragma unroll
        for (int j = 0; j < 4; ++j) { u32x2 w; w.x = cvtpk(v[r][j].x, v[r][j].y); w.y = cvtpk(v[r][j].z, v[r][j].w); o8[64 * j] = w; }
        if (lane == 0) rsout[mm[r]] = rs; }
}
struct WDesc { const float* W; int K, Nsrc, Npad; bf16_t* WT; };
DI void colmax_item(const float* W, const float* ksc, unsigned* cmax, int N, int it, int lane) {
    const int ncb = N >> 8, cb = it % ncb, kb = it / ncb, n = cb * 256 + lane * 4; f32x4 mx = {0.f, 0.f, 0.f, 0.f};
#pragma unroll
    for (int h = 0; h < 2; ++h) { f32x4 v[16];
#pragma unroll
        for (int kk = 0; kk < 16; ++kk) v[kk] = *(const f32x4*)(W + (size_t)(kb * 32 + h * 16 + kk) * N + n);
#pragma unroll
        for (int kk = 0; kk < 16; ++kk) { const float sc = ksc[kb * 32 + h * 16 + kk];
            mx.x = fmaxf(mx.x, fabsf(v[kk].x * sc)); mx.y = fmaxf(mx.y, fabsf(v[kk].y * sc)); mx.z = fmaxf(mx.z, fabsf(v[kk].z * sc)); mx.w = fmaxf(mx.w, fabsf(v[kk].w * sc)); } }
    atomicMax(cmax + n, __float_as_uint(mx.x)); atomicMax(cmax + n + 1, __float_as_uint(mx.y)); atomicMax(cmax + n + 2, __float_as_uint(mx.z)); atomicMax(cmax + n + 3, __float_as_uint(mx.w));
}
#ifndef Q8_MASK_V
#define Q8_MASK_V 0x54
#endif
constexpr int Q8_MASK = Q8_MASK_V;
DI int q8slot(int wsel) { return wsel == 0 ? 0 : (wsel == 2 ? 1 : (wsel == 4 ? 2 : 3)); }
#ifndef WT_RW
#define WT_RW 1
#define WT_GD 1
#endif
DI void p_weights(const Ctx& C, const float* const* in, unsigned char* ws, int wlo, int whi, bool with_rot, int gw, int NGW) {
    LAS float* scr = (LAS float*)(C.lds + C.wave * 16384);
    {
        const float* Wsrc[8] = {in[7], in[23], in[5], in[6], in[24], in[26], in[5] + (size_t)DM * FF, in[6] + (size_t)FF * DM};
        const int Kk[8] = {1024, 1024, 1024, 4096, 1024, 2048, 1024, 4096};
        const int Ns[8] = {AB_IN, 1024, 4096, 1024, RET_IN, 1024, 4096, 1024};
        const int Np[8] = {AB_PAD, 1024, 4096, 1024, RET_IN, 1024, 4096, 1024};
        const size_t off[8] = {W_IN0, W_OUT0, W_UP0, W_DN0, W_IN1, W_OUT1, W_UP1, W_DN1};
        const float* Ksc[8] = {in[1], nullptr, in[3], nullptr, in[1] + DM, nullptr, in[3] + DM, nullptr};
        int base = 0;
#pragma unroll
        for (int wsel = 0; wsel < 8; ++wsel) {
            if (wsel < wlo || wsel >= whi) continue;
            const int items = (Kk[wsel] / 64) * (Np[wsel] / 32);
            int first = gw - (base % NGW); if (first < 0) first += NGW;
            const bool q8 = (Q8_MASK >> wsel) & 1;
            const unsigned* cm = q8 ? (const unsigned*)(ws + WS_CMAX) + q8slot(wsel) * 6144 : nullptr;
            TrRegs L; const int lane = lane_id();
            if (first < items) tr_issue(L, Wsrc[wsel], Ksc[wsel], cm, Ns[wsel], Np[wsel], first, lane);
            for (int it = first; it < items; it += NGW) {
                tr_to_lds(L, q8, scr, lane);
                if (it + NGW < items) tr_issue(L, Wsrc[wsel], Ksc[wsel], cm, Ns[wsel], Np[wsel], it + NGW, lane);
                if (q8) tr_store_q(Kk[wsel], Np[wsel], (signed char*)(ws + off[wsel]), scr, it, lane); else tr_store(Kk[wsel], Np[wsel], (bf16_t*)(ws + off[wsel]), scr, it, lane);
            }
            if (q8) { float* swp = (float*)(ws + WS_SW) + q8slot(wsel) * 6144; for (int n = gw * 64 + lane; n < Ns[wsel]; n += NGW * 64) swp[n] = __uint_as_float(cm[n]) * (1.0f / 127.0f); }
            base += items;
        }
    }
    if (with_rot) {
        f32x2* rot = (f32x2*)(ws + WS_ROT); const int gt = gw * 64 + lane_id(), NT = NGW * 64;
        for (int i = gt; i < SEQ * 64; i += NT) { const int pos = i >> 6, j = i & 63;
            const float ang = 1.0f / powf(10000.0f, (float)j * (1.0f / 63.0f)); const float th = (float)pos * ang; float sn, cs; sincosf(th, &sn, &cs); rot[i] = (f32x2){cs, sn}; }
    }
}
DI void p_prologue(const Ctx& C, const float* const* in, unsigned char* ws) {
    const int gw = C.vcu * 8 + C.wave, NGW = C.G * 8;
    p_weights(C, in, ws, 0, 1, false, gw, NGW);
    {
        static_assert(Q8_MASK == 0x54, "colmax item list assumes in1, up0, up1");
        constexpr int I1 = (RET_IN / 256) * 32, I2 = (FF / 256) * 32; unsigned* cm = (unsigned*)(ws + WS_CMAX); const int lane = lane_id();
        for (int it = gw; it < I1 + 2 * I2; it += NGW) {
            if (it < I1) colmax_item(in[24], in[1] + DM, cm + 2 * 6144, RET_IN, it, lane);
            else if (it < I1 + I2) colmax_item(in[5], in[3], cm + 1 * 6144, FF, it - I1, lane);
            else colmax_item(in[5] + (size_t)DM * FF, in[3] + DM, cm + 3 * 6144, FF, it - I1 - I2, lane);
        }
    }
    {
        bf16_t* BL = (bf16_t*)(ws + W_LORA); const float* w2 = in[14]; const float* a2 = in[16]; const float* g2 = in[17];
        const int gt = (C.vcu * 8 + C.wave) * 64 + lane_id(), NT = C.G * 512;
        for (int i = gt; i < 1536 * 256; i += NT) { const int n = i >> 8, k = i & 255; float v = 0.f;
            if (n < 512) { if (k < 64) v = w2[k * 512 + n]; }
            else if (n < 1024) { if (k >= 64 && k < 128) v = a2[(k - 64) * 512 + (n - 512)]; }
            else { if (k >= 128) v = g2[(k - 128) * 512 + (n - 1024)]; }
            BL[i] = (bf16_t)(cvtpk(v, 0.f) & 0xffffu); }
    }
    bf16_t* U = (bf16_t*)(ws + R_U); float* RS = (float*)(ws + WS_RS);
    for (int m = gw; m < MTOK; m += 2 * NGW) rows2_to_bf16_rs(in[0], U, RS, m, (m + NGW < MTOK) ? m + NGW : m, lane_id());
}

DI void p_norm(const Ctx& C, const float* xbase, const bf16_t* hin, const bf16_t* mix, const float* wpost, bf16_t* hout, float* out32, float* RS, signed char* hq = nullptr) {
    const int gw = C.vcu * 8 + C.wave, NGW = C.G * 8, lane = lane_id();
    for (int m0 = gw; m0 < MTOK; m0 += 2 * NGW) {
        const int mm[2] = {m0, (m0 + NGW < MTOK) ? m0 + NGW : m0};
        u32x2 mw[2][4], hw[2][4]; f32x4 bv[2][4];
#pragma unroll
        for (int r = 0; r < 2; ++r) { const int m = mm[r]; const u32x2* mr = (const u32x2*)(mix + (size_t)m * DM) + lane;
#pragma unroll
            for (int j = 0; j < 4; ++j) { mw[r][j] = __builtin_nontemporal_load(mr + 64 * j);
                if (xbase) bv[r][j] = __builtin_nontemporal_load((const f32x4*)(xbase + (size_t)m * DM) + lane + 64 * j);
                else hw[r][j] = ((const u32x2*)(hin + (size_t)m * DM) + lane)[64 * j]; } }
#pragma unroll
        for (int r = 0; r < 2; ++r) { const int m = mm[r]; f32x4 mv[4]; float s = 0.f;
#pragma unroll
            for (int j = 0; j < 4; ++j) { const u32x2 w = mw[r][j]; mv[j] = (f32x4){bflo(w.x), bfhi(w.x), bflo(w.y), bfhi(w.y)};
                if (!xbase) { const u32x2 h = hw[r][j]; bv[r][j] = (f32x4){bflo(h.x), bfhi(h.x), bflo(h.y), bfhi(h.y)}; }
                s += (mv[j].x * mv[j].x + mv[j].y * mv[j].y) + (mv[j].z * mv[j].z + mv[j].w * mv[j].w); }
            const float rs = __builtin_amdgcn_rsqf(wave_sum(s) * (1.f / DM) + RMS_EPS);
            float s2 = 0.f; f32x4* b = bv[r];
#pragma unroll
            for (int j = 0; j < 4; ++j) { const f32x4 wp = ((const f32x4*)wpost)[64 * j + lane]; b[j] = b[j] + mv[j] * rs * wp;
                s2 += (b[j].x * b[j].x + b[j].y * b[j].y) + (b[j].z * b[j].z + b[j].w * b[j].w); }
            if (out32) { f32x4* ho = (f32x4*)(out32 + (size_t)m * DM) + lane;
#pragma unroll
                for (int j = 0; j < 4; ++j) ho[64 * j] = b[j]; }
            if (hout) {
                const float rs2 = __builtin_amdgcn_rsqf(wave_sum(s2) * (1.f / DM) + RMS_EPS);
                u32x2* uo = (u32x2*)(hout + (size_t)m * DM) + lane;
#pragma unroll
                for (int j = 0; j < 4; ++j) { u32x2 o; o.x = cvtpk(b[j].x, b[j].y); o.y = cvtpk(b[j].z, b[j].w); uo[64 * j] = o; }
                float cs = rs2;
                if (hq) {
                    float amax = 0.f;
#pragma unroll
                    for (int j = 0; j < 4; ++j) amax = fmaxf(amax, fmaxf(fmaxf(fabsf(b[j].x), fabsf(b[j].y)), fmaxf(fabsf(b[j].z), fabsf(b[j].w))));
                    amax = fmaxf(wave_max(amax), 1e-20f); const float inv = 127.0f * __builtin_amdgcn_rcpf(amax); cs = rs2 * amax * (1.0f / 127.0f);
                    unsigned* qo = (unsigned*)(hq + (size_t)m * DM) + lane;
#pragma unroll
                    for (int j = 0; j < 4; ++j) { const int q0 = (int)rintf(b[j].x * inv), q1 = (int)rintf(b[j].y * inv), q2 = (int)rintf(b[j].z * inv), q3 = (int)rintf(b[j].w * inv);
                        qo[64 * j] = ((unsigned)q0 & 0xffu) | (((unsigned)q1 & 0xffu) << 8) | (((unsigned)q2 & 0xffu) << 16) | (((unsigned)q3 & 0xffu) << 24); }
                }
                if (lane == 0) RS[m] = cs;
            }
        }
    }
}

DI void p_lora_pre(const Ctx& C, const bf16_t* p0, const float* mu, bf16_t* AP) {
    const int gt = (C.vcu * 8 + C.wave) * 64 + lane_id(), NT = C.G * 512;
    const int j0 = (gt & 31) * 8; float mv[8];
#pragma unroll
    for (int e = 0; e < 8; ++e) mv[e] = mu[1536 + j0 + e];
    constexpr int NB = 4;
    for (int i0 = gt; i0 < MTOK * 32; i0 += NB * NT) {
        u32x4 cur[NB], prv[NB];
#pragma unroll
        for (int q = 0; q < NB; ++q) { const int m = (i0 + q * NT) >> 5; cur[q] = *(const u32x4*)(p0 + (size_t)m * AB_PAD + 3600 + j0); prv[q] = (u32x4){0u, 0u, 0u, 0u};
            if ((m & (SEQ - 1)) != 0) prv[q] = *(const u32x4*)(p0 + (size_t)(m - 1) * AB_PAD + 3600 + j0); }
#pragma unroll
        for (int q = 0; q < NB; ++q) { const int m = (i0 + q * NT) >> 5; float c[8], p[8], o[8]; unpack8(cur[q], c); unpack8(prv[q], p);
#pragma unroll
            for (int e = 0; e < 8; ++e) { const float xs = c[e] + (p[e] - c[e]) * mv[e];
                o[e] = (j0 < 64) ? (1.0f - 2.0f * __builtin_amdgcn_rcpf(1.0f + __expf(2.0f * xs))) : (j0 < 128 ? xs : sigmoidf_(xs)); }
            *(u32x4*)(AP + (size_t)m * 256 + j0) = pack8(o); }
    }
}

struct ScanArgs { const bf16_t* p0; bf16_t* oab; bf16_t* EB; const float* conv_w; const float* a_log; const float* dt_bias; const float* gnw;
    const float* mu; const float* k_k; const float* k_a; const float* r_k; const float* ln_w; const float* ln_b; const bf16_t* LW; const bf16_t* AA; const bf16_t* GT; };
DI void p_mix_post(const Ctx& C, const ScanArgs& A) {
    const int gt = (C.vcu * 8 + C.wave) * 64 + lane_id(), NT = C.G * 512;
    for (int i = gt; i < MTOK * 128; i += NT) {
        const int m = i >> 7, ch = (i & 127) * 8, hs = ch >> 6; bf16_t* p = A.oab + (size_t)m * DM + ch;
        float y[8]; unpack8(*(const u32x4*)p, y);
        if (hs < 8) {
            float ss = 0.f;
#pragma unroll
            for (int e = 0; e < 8; ++e) ss += y[e] * y[e];
            ss = red8(ss); const float r = __builtin_amdgcn_rsqf(ss * (1.f / 64.f) + RMS_EPS);
            float z[8]; unpack8(*(const u32x4*)(A.p0 + (size_t)m * AB_PAD + 1536 + ch), z);
#pragma unroll
            for (int e = 0; e < 8; ++e) y[e] = y[e] * r * A.gnw[(ch & 63) + e] * siluf_(z[e]);
        } else {
            const int cc = ch - 512; float s1 = 0.f;
#pragma unroll
            for (int e = 0; e < 8; ++e) s1 += y[e];
            const float mean = red8(s1) * (1.f / 64.f); float s2 = 0.f;
#pragma unroll
            for (int e = 0; e < 8; ++e) { y[e] -= mean; s2 += y[e] * y[e]; }
            const float rstd = __builtin_amdgcn_rsqf(red8(s2) * (1.f / 64.f) + 64e-5f);
            float gtv[8], eb[8]; unpack8(*(const u32x4*)(A.GT + (size_t)m * 512 + cc), gtv); unpack8(*(const u32x4*)(A.EB + (size_t)m * 512 + cc), eb);
#pragma unroll
            for (int e = 0; e < 8; ++e) y[e] = y[e] * rstd * A.ln_w[cc + e] * gtv[e] + eb[e];
        }
        *(u32x4*)p = pack8(y);
    }
}

constexpr int RC = 64;
constexpr int RSEG = 4, RSEGLEN = SEQ / RSEG;
constexpr int QP = 136, KDP = 160, VP = 288, PP = 72;
constexpr int L_GT = 0;
constexpr int L_Q = 512, L_K = L_Q + RC * QP * 2, L_KD = L_K + RC * QP * 2, L_V = L_KD + RC * KDP * 2, L_P = L_V + RC * VP * 2, L_END = L_P + RC * PP * 2;
constexpr int OSP = 260;
static_assert(L_END <= RING_BYTES && 512 + RC * OSP * 4 <= L_P, "retention LDS");
DI int crow(int reg, int hh) { return (reg & 3) + 8 * (reg >> 2) + 4 * hh; }
DI bf16x8 frag_contig(const LAS bf16_t* p) { return *(const LAS bf16x8*)p; }
typedef short v4i16_t __attribute__((ext_vector_type(4)));
DI bf16x8 frag_tr(const LAS bf16_t* tile, int pitch, int krow0, int n0, int lane) {
    const int hh = lane >> 5, blk = (lane >> 4) & 1, q = (lane & 15) >> 2, p = lane & 3;
    const LAS bf16_t* a = tile + (krow0 + 8 * hh + q) * pitch + n0 + 16 * blk + 4 * p;
    const s16x4 lo = __builtin_bit_cast(s16x4, __builtin_amdgcn_ds_read_tr16_b64_v4i16((LAS v4i16_t*)a));
    const s16x4 hi = __builtin_bit_cast(s16x4, __builtin_amdgcn_ds_read_tr16_b64_v4i16((LAS v4i16_t*)(a + 4 * pitch)));
    return __builtin_shufflevector(lo, hi, 0, 1, 2, 3, 4, 5, 6, 7);
}
DI bf16x8 frag_tr_perm(const LAS bf16_t* tile, int pitch, int s, int n0, int lane) {
    const int hh = lane >> 5, blk = (lane >> 4) & 1, q = (lane & 15) >> 2, p = lane & 3;
    const LAS bf16_t* a = tile + (16 * s + 4 * hh + q) * pitch + n0 + 16 * blk + 4 * p;
    const s16x4 lo = __builtin_bit_cast(s16x4, __builtin_amdgcn_ds_read_tr16_b64_v4i16((LAS v4i16_t*)a));
    const s16x4 hi = __builtin_bit_cast(s16x4, __builtin_amdgcn_ds_read_tr16_b64_v4i16((LAS v4i16_t*)(a + 8 * pitch)));
    return __builtin_shufflevector(lo, hi, 0, 1, 2, 3, 4, 5, 6, 7);
}
DI bf16x8 frag_perm(const LAS bf16_t* p) { const s16x4 lo = *(const LAS s16x4*)p, hi = *(const LAS s16x4*)(p + 8); return __builtin_shufflevector(lo, hi, 0, 1, 2, 3, 4, 5, 6, 7); }
DI bf16x8 pack_step(const f32x16& x, int s) { u32x4 p; p.x = cvtpk(x[8 * s], x[8 * s + 1]); p.y = cvtpk(x[8 * s + 2], x[8 * s + 3]); p.z = cvtpk(x[8 * s + 4], x[8 * s + 5]); p.w = cvtpk(x[8 * s + 6], x[8 * s + 7]); return __builtin_bit_cast(bf16x8, p); }
#define MFMA32(a, b, c) __builtin_amdgcn_mfma_f32_32x32x16_bf16((a), (b), (c), 0, 0, 0)

namespace ck {
constexpr int CL = 32, NCH = SEQ / CL;
constexpr int AP = 72, TP = 40, NP = 36;
constexpr int O_AT = 0, O_RT = O_AT + 4608, O_BN = O_RT + 4608, O_KN = O_BN + 4608, O_V = O_KN + 4608, O_CL = O_V + 2048, TBSZ = O_CL + 256;
constexpr int O_TM = 0, O_NLO = O_TM + 2560, O_NAK = O_NLO + 2560, O_NBR = O_NAK + 2560, O_NKR = O_NBR + 2560, TNSZ = O_NKR + 2560;
constexpr int O_TB = 0, O_TN = O_TB + 4 * TBSZ, O_NAB = O_TN + 2 * TNSZ, O_TOT = O_NAB + 32 * NP * 4, O_CW = O_TOT + 2048, O_ST = O_CW + 2560, O_FLAG = O_ST + 8192, O_END = O_FLAG + 16;
static_assert(O_END <= RING_BYTES, "chunk-scan LDS");
}
#define CK_BAR() do { asm volatile("s_waitcnt lgkmcnt(0)" ::: "memory"); __builtin_amdgcn_s_barrier(); asm volatile("" ::: "memory"); } while (0)

template <bool RWKV>
DI void chunk_task(const Ctx& C, const ScanArgs& A, int b, int h, int half) {
    using namespace ck;
    int lane = lane_id(), tid = C.wave * 64 + lane, r = lane & 31, hh = lane >> 5; const int w = C.wave;
    LAS float* Nab = (LAS float*)(C.lds + O_NAB); LAS float* tot = (LAS float*)(C.lds + O_TOT); LAS float* cw = (LAS float*)(C.lds + O_CW);
    int pt = (tid >> 3) & 31, ps = tid & 7;
    bool own = (ps >> 2) == half;
    __syncthreads();
    float nalog = 0.f, dtb = 0.f;
    if (RWKV) { if (tid < 448) { const int a_ = tid >> 6, ch = tid & 63; const float* src = a_ == 0 ? A.mu : (a_ == 1 ? A.mu + 512 : (a_ == 2 ? A.mu + 1024 : (a_ == 3 ? A.k_k : (a_ == 4 ? A.k_a : (a_ == 5 ? A.r_k : A.ln_b))))); cw[tid] = src[h * 64 + ch]; } }
    if (!RWKV) { nalog = -__expf(A.a_log[h]); dtb = A.dt_bias[h];
        for (int i = tid; i < 640; i += 512) { const int j = i / 160, ch = i % 160; const int col = ch < 64 ? h * 64 + ch : (ch < 128 ? 512 + h * 64 + (ch - 64) : 1024 + h * 64 + 32 * half + (ch - 128)); cw[i] = A.conv_w[j * 1536 + col]; } }
    __syncthreads();
    u32x4 L0[4], L1[4], L2[4];
    unsigned short araw = 0, braw = 0;
    auto ldq = [](const bf16_t* base, unsigned boff) { return *(const u32x4*)((const char*)base + boff); };
    auto issue = [&](int c) {
        const int t0 = c * CL; const u32x4 Z4 = {0u, 0u, 0u, 0u};
        if (RWKV) {
            const size_t mu_ = (size_t)b * SEQ + t0; const bf16_t* rb = A.p0 + mu_ * AB_PAD + RP0 + h * 64; const bf16_t* rp = rb - AB_PAD;
            const unsigned o = ((unsigned)pt * AB_PAD + 8u * ps) * 2u, o5 = ((unsigned)pt * 512u + 8u * ps) * 2u; const bool hp = (t0 + pt) != 0;
            L0[0] = ldq(rb, o); L0[2] = ldq(rb, o + 1024u); L0[1] = Z4; L0[3] = Z4; L1[0] = Z4; L1[1] = Z4; L2[0] = Z4;
            if (hp) { L0[1] = ldq(rp, o); L0[3] = ldq(rp, o + 1024u); }
            if (own) { L1[0] = ldq(rb, o + 2048u); if (hp) L1[1] = ldq(rp, o + 2048u); L2[0] = ldq(A.GT + mu_ * 512 + h * 64, o5); }
            L1[2] = ldq(A.LW + mu_ * 512 + h * 64, o5); L1[3] = ldq(A.AA + mu_ * 512 + h * 64, o5);
        } else {
            const bf16_t* rb = A.p0 + ((size_t)b * SEQ + t0) * AB_PAD + h * 64;
#pragma unroll
            for (int tp = 0; tp < 4; ++tp) { const int ts = t0 + pt - 3 + tp; L0[tp] = Z4; L1[tp] = Z4;
                if (ts >= 0) { const bf16_t* rt_ = rb - (3 - tp) * AB_PAD; const unsigned o = ((unsigned)pt * AB_PAD + 8u * ps) * 2u; L0[tp] = ldq(rt_, o); L1[tp] = ldq(rt_, o + 1024u); } }
            { const unsigned o = ((unsigned)pt * AB_PAD) * 2u; const char* sb = (const char*)(rb - h * 64 + 2048 + h); braw = *(const bf16_t*)(sb + o); araw = *(const bf16_t*)(sb + o + 16u); }
        }
    };
    auto issue_v = [&](int c) {
        const int idx = (w - 5) * 64 + lane, vt = idx >> 2, vg = idx & 3;
        const bf16_t* rb = A.p0 + ((size_t)b * SEQ + c * CL) * AB_PAD + 1024 + h * 64 + 32 * half;
#pragma unroll
        for (int tp = 0; tp < 4; ++tp) { const int ts = c * CL + vt - 3 + tp; L2[tp] = (u32x4){0u, 0u, 0u, 0u};
            if (ts >= 0) L2[tp] = ldq(rb - (3 - tp) * AB_PAD, ((unsigned)vt * AB_PAD + 8u * vg) * 2u); }
    };
    auto conv8 = [&](const u32x4* rr, int wch, float* out) {
        float acc[8] = {0.f, 0.f, 0.f, 0.f, 0.f, 0.f, 0.f, 0.f};
#pragma unroll
        for (int tp = 0; tp < 4; ++tp) { float x[8]; unpack8(rr[tp], x);
            const f32x4 w0 = *(const LAS f32x4*)(cw + tp * 160 + wch), w1 = *(const LAS f32x4*)(cw + tp * 160 + wch + 4);
            acc[0] += w0.x * x[0]; acc[1] += w0.y * x[1]; acc[2] += w0.z * x[2]; acc[3] += w0.w * x[3];
            acc[4] += w1.x * x[4]; acc[5] += w1.y * x[5]; acc[6] += w1.z * x[6]; acc[7] += w1.w * x[7]; }
#pragma unroll
        for (int e = 0; e < 8; ++e) out[e] = siluf_(acc[e]);
    };
    float vlw[8], vci[8]; u32x4 pkk, pb, pk, pr;
    auto stage1 = [&](int c) {
        LAS bf16_t* Vv = (LAS bf16_t*)(C.lds + O_TB + (c & 3) * TBSZ + O_V);
        const size_t m = (size_t)b * SEQ + c * CL + pt; float v8[8], vkk[8], vb[8], vk[8], vr[8];
        if (RWKV) {
            const int pc = h * 64 + 8 * ps; float x[8], y[8], kr[8], a[8]; const LAS float* pw = cw + 8 * ps;
            unpack8(L0[0], x); unpack8(L0[1], y);
#pragma unroll
            for (int e = 0; e < 8; ++e) vr[e] = x[e] + (y[e] - x[e]) * pw[e];
            unpack8(L0[2], x); unpack8(L0[3], y);
#pragma unroll
            for (int e = 0; e < 8; ++e) kr[e] = x[e] + (y[e] - x[e]) * pw[64 + e];
            unpack8(L1[0], x); unpack8(L1[1], y);
#pragma unroll
            for (int e = 0; e < 8; ++e) v8[e] = x[e] + (y[e] - x[e]) * pw[128 + e];
            unpack8(L1[2], vlw); unpack8(L1[3], a);
            float kx[8], skk = 0.f;
#pragma unroll
            for (int e = 0; e < 8; ++e) { kx[e] = kr[e] * pw[192 + e]; skk += kx[e] * kx[e]; }
            skk = red8(skk); const float rn = __builtin_amdgcn_rsqf(skk + 1e-6f); float rkr = 0.f;
#pragma unroll
            for (int e = 0; e < 8; ++e) { vkk[e] = kx[e] * rn; vk[e] = kr[e] * (1.0f + (a[e] - 1.0f) * pw[256 + e]); vb[e] = vkk[e] * a[e]; rkr += vr[e] * vk[e] * pw[320 + e]; }
            rkr = red8(rkr);
            if (own) { float gt[8], eo[8]; unpack8(L2[0], gt);
#pragma unroll
                for (int e = 0; e < 8; ++e) eo[e] = (pw[384 + e] + rkr * v8[e]) * gt[e];
                *(u32x4*)(A.EB + m * 512 + pc) = pack8(eo); }
        } else {
            float q[8], k[8]; conv8(L0, 8 * ps, q); conv8(L1, 64 + 8 * ps, k);
            float sq = 0.f, sk = 0.f;
#pragma unroll
            for (int e = 0; e < 8; ++e) { sq += q[e] * q[e]; sk += k[e] * k[e]; }
            sq = red8(sq); sk = red8(sk);
            const float rq_ = 0.125f * __builtin_amdgcn_rsqf(sq + 1e-6f), rk_ = __builtin_amdgcn_rsqf(sk + 1e-6f);
            const float beta = sigmoidf_(bf1(braw)), gl = nalog * softplusf_(bf1(araw) + dtb), al = __expf(gl);
#pragma unroll
            for (int e = 0; e < 8; ++e) { const float kh = k[e] * rk_; vkk[e] = kh; vb[e] = al * beta * kh; vk[e] = beta * kh; vr[e] = q[e] * rq_; vlw[e] = gl; }
        }
        if (RWKV) { if (own) *(LAS u32x4*)(Vv + pt * 32 + 8 * (ps & 3)) = pack8(v8); }
        pkk = pack8(vkk); pb = pack8(vb); pk = pack8(vk); pr = pack8(vr);
        const int tl = lane >> 3;
        if (!RWKV) { float x = vlw[0];
            float y1 = __shfl_up(x, 8);  if (tl >= 1) x += y1;
            float y2 = __shfl_up(x, 16); if (tl >= 2) x += y2;
            float y4 = __shfl_up(x, 32); if (tl >= 4) x += y4;
#pragma unroll
            for (int e = 0; e < 8; ++e) vci[e] = x; }
        else
#pragma unroll
        for (int e = 0; e < 8; ++e) { float x = vlw[e];
            float y1 = __shfl_up(x, 8);  if (tl >= 1) x += y1;
            float y2 = __shfl_up(x, 16); if (tl >= 2) x += y2;
            float y4 = __shfl_up(x, 32); if (tl >= 4) x += y4;
            vci[e] = x; }
        if (tl == 7) { LAS float* tp_ = tot + (c & 1) * 256 + (pt >> 3) * 64 + 8 * ps; *(LAS f32x4*)tp_ = (f32x4){vci[0], vci[1], vci[2], vci[3]}; *(LAS f32x4*)(tp_ + 4) = (f32x4){vci[4], vci[5], vci[6], vci[7]}; }
    };
    auto stage3 = [&](int c) {
        LAS unsigned char* S_ = C.lds + O_TB + (c & 3) * TBSZ;
        LAS bf16_t* At = (LAS bf16_t*)(S_ + O_AT); LAS bf16_t* Rt = (LAS bf16_t*)(S_ + O_RT); LAS bf16_t* Bn = (LAS bf16_t*)(S_ + O_BN); LAS bf16_t* Kn = (LAS bf16_t*)(S_ + O_KN);
        const int wv = pt >> 3; float off[8] = {0.f, 0.f, 0.f, 0.f, 0.f, 0.f, 0.f, 0.f};
#pragma unroll
        for (int q = 0; q < 3; ++q) if (q < wv) { if (!RWKV) { off[0] += tot[(c & 1) * 256 + q * 64 + 8 * ps]; continue; }
            const f32x4 t0 = *(const LAS f32x4*)(tot + (c & 1) * 256 + q * 64 + 8 * ps), t1 = *(const LAS f32x4*)(tot + (c & 1) * 256 + q * 64 + 8 * ps + 4);
            off[0] += t0.x; off[1] += t0.y; off[2] += t0.z; off[3] += t0.w; off[4] += t1.x; off[5] += t1.y; off[6] += t1.z; off[7] += t1.w; }
        float at[8], rt[8], bt[8], kt[8], cl[8], vkk[8], vb[8], vk[8], vr[8]; unpack8(pkk, vkk); unpack8(pb, vb); unpack8(pk, vk); unpack8(pr, vr);
        if (!RWKV) {
            const float cI = vci[0] + off[0], cX = cI - vlw[0]; const float eI = __expf(cI), enI = __builtin_amdgcn_rcpf(eI), eX = __expf(cX);
#pragma unroll
            for (int e = 0; e < 8; ++e) { at[e] = vkk[e] * eX; rt[e] = vr[e] * eI; bt[e] = -vb[e] * enI; kt[e] = vk[e] * enI; cl[e] = eI; }
        } else
#pragma unroll
        for (int e = 0; e < 8; ++e) { const float cI = vci[e] + off[e], cX = cI - vlw[e]; const float eI = __expf(cI), enI = __expf(-cI), eX = __expf(cX);
            at[e] = vkk[e] * eX; rt[e] = vr[e] * eI; bt[e] = -vb[e] * enI; kt[e] = vk[e] * enI; cl[e] = eI; }
        *(LAS u32x4*)(At + pt * AP + 8 * ps) = pack8(at); *(LAS u32x4*)(Rt + pt * AP + 8 * ps) = pack8(rt);
        *(LAS u32x4*)(Bn + pt * AP + 8 * ps) = pack8(bt); *(LAS u32x4*)(Kn + pt * AP + 8 * ps) = pack8(kt);
        if (pt == CL - 1) { LAS float* cp = (LAS float*)(S_ + O_CL) + 8 * ps; *(LAS f32x4*)cp = (f32x4){cl[0], cl[1], cl[2], cl[3]}; *(LAS f32x4*)(cp + 4) = (f32x4){cl[4], cl[5], cl[6], cl[7]}; }
    };
    auto gram_tile = [&](int c, int tile, f32x16& g) {
        LAS unsigned char* S_ = C.lds + O_TB + (c & 3) * TBSZ;
        const LAS bf16_t* GA = (const LAS bf16_t*)(S_ + ((tile < 2) ? O_AT : O_RT)); const LAS bf16_t* GB = (const LAS bf16_t*)(S_ + ((tile & 1) ? O_KN : O_BN));
#pragma unroll
        for (int e = 0; e < 16; ++e) g[e] = 0.f;
#pragma unroll
        for (int ks = 0; ks < 4; ++ks) g = MFMA32(frag_contig(GA + r * AP + 16 * ks + 8 * hh), frag_contig(GB + r * AP + 16 * ks + 8 * hh), g);
    };
    auto put_tile = [&](LAS bf16_t* dst, const f32x16& g, bool strict) {
#pragma unroll
        for (int e = 0; e < 16; ++e) { const int t = crow(e, hh), s_ = r; const float val = (strict ? (s_ < t) : (s_ <= t)) ? g[e] : 0.f; dst[t * TP + s_] = (bf16_t)(cvtpk(val, 0.f) & 0xffffu); }
    };
    LAS f32x4* stp = (LAS f32x4*)(C.lds + O_ST);
    if (w == 7) {
#pragma unroll
        for (int q = 0; q < 8; ++q) stp[q * 64 + lane] = (f32x4){0.f, 0.f, 0.f, 0.f};
        if (lane == 0) *(volatile LAS int*)(C.lds + O_FLAG) = 0; }
    bf16_t* ydst = A.oab + (size_t)b * SEQ * DM + (RWKV ? 512 : 0) + h * 64 + 32 * half;
    if (w >= 4) __builtin_amdgcn_s_setprio(2);
    for (int j = 0; j < NCH + 3; ++j) {
        asm volatile("" : "+v"(lane));
        tid = w * 64 + lane; r = lane & 31; hh = lane >> 5; pt = (tid >> 3) & 31; ps = tid & 7; own = (ps >> 2) == half;
        const bool vecs = (w < 4) && (j < NCH), vecs3 = (w < 4) && (j >= 1) && (j <= NCH), gram = (w >= 4 && w < 7) && (j >= 2) && (j <= NCH + 1), seq = (w == 7) && (j >= 3);
        LAS unsigned char* TNw = C.lds + O_TN + ((j - 2) & 1) * TNSZ;
        if (vecs3) stage3(j - 1);
        if (vecs) { if (j == 0) issue(0); stage1(j); if (j + 1 < NCH) issue(j + 1); }
        if (gram && w == 6) {
            f32x16 g; gram_tile(j - 2, 0, g);
#pragma unroll
            for (int e = 0; e < 16; ++e) { const int t = crow(e, hh), s_ = r; const float nv = (s_ < t) ? -g[e] : 0.f; Nab[t * NP + s_] = nv;
                ((LAS bf16_t*)(TNw + O_NLO))[t * TP + s_] = (bf16_t)(cvtpk((t >= 16 && s_ < 16) ? -nv : 0.f, 0.f) & 0xffffu); }
            asm volatile("s_waitcnt lgkmcnt(0)" ::: "memory");
            *(volatile LAS int*)(C.lds + O_FLAG) = j;
        }
        if (!RWKV && (w == 5 || w == 6) && j < NCH) {
            if (j == 0) issue_v(0);
            const int idx = (w - 5) * 64 + lane, vt = idx >> 2, vg = idx & 3; float v8[8]; conv8(L2, 128 + 8 * vg, v8);
            *(LAS u32x4*)((LAS bf16_t*)(C.lds + O_TB + (j & 3) * TBSZ + O_V) + vt * 32 + 8 * vg) = pack8(v8);
            if (j + 1 < NCH) issue_v(j + 1);
        }
        if (gram) {
            f32x16 g;
            if (w == 4) { while (*(volatile LAS int*)(C.lds + O_FLAG) != j) __builtin_amdgcn_s_sleep(1);
                asm volatile("s_waitcnt lgkmcnt(0)" ::: "memory");
            {
            LAS bf16_t* Tm = (LAS bf16_t*)(TNw + O_TM); float Tr[16]; const int jb = (lane >> 4) & 1, jc = lane & 15;
            const LAS float* Nb = Nab + (16 * jb) * NP + 16 * jb;
#pragma unroll
            for (int i = 0; i < 16; ++i) { float a0 = (i == jc) ? 1.f : 0.f, a1 = 0.f, a2 = 0.f, a3 = 0.f;
#pragma unroll
                for (int k4 = 0; k4 < i; k4 += 4) { const f32x4 n4 = *(const LAS f32x4*)(Nb + i * NP + k4);
                    a0 -= n4.x * Tr[k4]; if (k4 + 1 < i) a1 -= n4.y * Tr[k4 + 1]; if (k4 + 2 < i) a2 -= n4.z * Tr[k4 + 2]; if (k4 + 3 < i) a3 -= n4.w * Tr[k4 + 3]; }
                Tr[i] = (a0 + a1) + (a2 + a3);
                if (hh == 0) { Tm[(16 * jb + i) * TP + 16 * jb + jc] = (bf16_t)(cvtpk(Tr[i], 0.f) & 0xffffu); Tm[(16 * jb + i) * TP + 16 * (1 - jb) + jc] = (bf16_t)0; } }
        }
            }
            else if (w == 5) { gram_tile(j - 2, 1, g); put_tile((LAS bf16_t*)(TNw + O_NAK), g, true); gram_tile(j - 2, 2, g); put_tile((LAS bf16_t*)(TNw + O_NBR), g, false); }
            else { gram_tile(j - 2, 3, g); put_tile((LAS bf16_t*)(TNw + O_NKR), g, false); }
        }
        if (seq) {
            const int c = j - 3; LAS unsigned char* Q_ = C.lds + O_TB + (c & 3) * TBSZ; LAS unsigned char* R_ = C.lds + O_TN + (c & 1) * TNSZ;
            LAS bf16_t* qAt = (LAS bf16_t*)(Q_ + O_AT); LAS bf16_t* qRt = (LAS bf16_t*)(Q_ + O_RT); LAS bf16_t* qnBn = (LAS bf16_t*)(Q_ + O_BN); LAS bf16_t* qKn = (LAS bf16_t*)(Q_ + O_KN);
            LAS bf16_t* qV = (LAS bf16_t*)(Q_ + O_V); LAS float* qcL = (LAS float*)(Q_ + O_CL);
            LAS bf16_t* qTm = (LAS bf16_t*)(R_ + O_TM); LAS bf16_t* qNlo = (LAS bf16_t*)(R_ + O_NLO); LAS bf16_t* qNak = (LAS bf16_t*)(R_ + O_NAK); LAS bf16_t* qNbr = (LAS bf16_t*)(R_ + O_NBR); LAS bf16_t* qNkr = (LAS bf16_t*)(R_ + O_NKR);
            f32x16 X, D, Y, E, St[2]; bf16x8 vf[2];
#pragma unroll
            for (int i = 0; i < 2; ++i)
#pragma unroll
                for (int q = 0; q < 4; ++q) { const f32x4 t4 = stp[(4 * i + q) * 64 + lane]; St[i][4 * q] = t4.x; St[i][4 * q + 1] = t4.y; St[i][4 * q + 2] = t4.z; St[i][4 * q + 3] = t4.w; }
#pragma unroll
            for (int ks = 0; ks < 2; ++ks) vf[ks] = frag_tr(qV, 32, 16 * ks, 0, lane);
#pragma unroll
            for (int e = 0; e < 16; ++e) { X[e] = 0.f; D[e] = 0.f; Y[e] = 0.f; E[e] = 0.f; }
#pragma unroll
            for (int i = 0; i < 2; ++i)
#pragma unroll
                for (int s = 0; s < 2; ++s) { const bf16x8 sb = pack_step(St[i], s);
                    X = MFMA32(frag_perm(qAt + r * AP + 32 * i + 16 * s + 4 * hh), sb, X);
                    Y = MFMA32(frag_perm(qRt + r * AP + 32 * i + 16 * s + 4 * hh), sb, Y); }
#pragma unroll
            for (int ks = 0; ks < 2; ++ks) { X = MFMA32(frag_contig(qNak + r * TP + 16 * ks + 8 * hh), vf[ks], X); Y = MFMA32(frag_contig(qNkr + r * TP + 16 * ks + 8 * hh), vf[ks], Y); }
#pragma unroll
            for (int s = 0; s < 2; ++s) D = MFMA32(frag_perm(qTm + r * TP + 16 * s + 4 * hh), pack_step(X, s), D);
#pragma unroll
            for (int s = 0; s < 2; ++s) E = MFMA32(frag_perm(qNlo + r * TP + 16 * s + 4 * hh), pack_step(D, s), E);
#pragma unroll
            for (int s = 0; s < 2; ++s) D = MFMA32(frag_perm(qTm + r * TP + 16 * s + 4 * hh), pack_step(E, s), D);
#pragma unroll
            for (int s = 0; s < 2; ++s) { const bf16x8 db = pack_step(D, s);
                Y = MFMA32(frag_perm(qNbr + r * TP + 16 * s + 4 * hh), db, Y);
#pragma unroll
                for (int i = 0; i < 2; ++i) St[i] = MFMA32(frag_tr_perm(qnBn, AP, s, 32 * i, lane), db, St[i]); }
#pragma unroll
            for (int i = 0; i < 2; ++i) {
#pragma unroll
                for (int ks = 0; ks < 2; ++ks) St[i] = MFMA32(frag_tr(qKn, AP, 16 * ks, 32 * i, lane), vf[ks], St[i]);
#pragma unroll
                for (int e = 0; e < 16; ++e) St[i][e] *= qcL[32 * i + crow(e, hh)];
#pragma unroll
                for (int q = 0; q < 4; ++q) stp[(4 * i + q) * 64 + lane] = (f32x4){St[i][4 * q], St[i][4 * q + 1], St[i][4 * q + 2], St[i][4 * q + 3]}; }
            bf16_t* yp = ydst + (size_t)c * CL * DM + r;
#pragma unroll
            for (int e = 0; e < 16; ++e) yp[(size_t)crow(e, hh) * DM] = (bf16_t)(cvtpk(Y[e], 0.f) & 0xffffu);
        }
        CK_BAR();
    }
    __builtin_amdgcn_s_setprio(0);
}

template <bool PRE>
DI void ret_unit(const Ctx& C, bf16_t* p1, float* SEG, const float* gnw, int bh, int seg) {
    const int lane = lane_id(), tid = C.wave * 64 + lane, w = C.wave, r = lane & 31, hh = lane >> 5, d0 = 32 * w;
    const int b = bh >> 3, h = bh & 7;
    LAS bf16_t* Qs = (LAS bf16_t*)(C.lds + L_Q); LAS bf16_t* Ks = (LAS bf16_t*)(C.lds + L_K); LAS bf16_t* Kd = (LAS bf16_t*)(C.lds + L_KD);
    LAS bf16_t* Vs = (LAS bf16_t*)(C.lds + L_V); LAS bf16_t* Ps = (LAS bf16_t*)(C.lds + L_P); LAS float* Os = (LAS float*)(C.lds + 512);
    const float lg2 = log2f(1.0f - exp2f(-5.0f - (float)h));
    const float g64 = exp2f(lg2 * 64.f);
    LAS float* gtab = (LAS float*)(C.lds + L_GT);
    __syncthreads();
    if (tid <= 64) gtab[tid] = exp2f(lg2 * (float)tid);
    LAS float* gls = (LAS float*)(C.lds + RING_BYTES + 1024);
    if (!PRE && tid < 256) gls[tid] = gnw[h * 256 + tid];
    __syncthreads();
    f32x16 St[4];
#pragma unroll
    for (int i = 0; i < 4; ++i)
#pragma unroll
        for (int e = 0; e < 16; ++e) St[i][e] = 0.f;
    if (!PRE) {
        for (int sp = 0; sp < seg; ++sp) {
            const float f = exp2f(lg2 * (float)(RSEGLEN * (seg - 1 - sp)));
            const float* src = SEG + ((size_t)(bh * 3 + sp) * 8 + w) * 4096 + lane;
#pragma unroll
            for (int i = 0; i < 4; ++i)
#pragma unroll
                for (int e = 0; e < 16; ++e) St[i][e] += f * src[(i * 16 + e) * 64];
        }
    }
    u32x4 rq[2], rk[2], rv[4];
    auto gload = [&](int ch) {
        const size_t tt = (size_t)bh * SEQ, t0 = (size_t)seg * RSEGLEN + ch * RC;
#pragma unroll
        for (int i = 0; i < 2; ++i) { const int item = tid + 512 * i;
            if (!PRE) rq[i] = *(const u32x4*)(p1 + P1_Q + (tt + t0) * 128 + (size_t)item * 8);
            rk[i] = *(const u32x4*)(p1 + P1_K + (tt + t0) * 128 + (size_t)item * 8); }
#pragma unroll
        for (int i = 0; i < 4; ++i) { const int item = tid + 512 * i; rv[i] = *(const u32x4*)(p1 + P1_V + (tt + t0) * 256 + (size_t)item * 8); }
    };
    gload(0);
    for (int ch = 0; ch < RSEGLEN / RC; ++ch) {
        const size_t m0 = (size_t)b * SEQ + seg * RSEGLEN + ch * RC;
#pragma unroll
        for (int i = 0; i < 2; ++i) { const int item = tid + 512 * i, j = item >> 4, c = item & 15;
            if (!PRE) { *(LAS u32x4*)(Qs + j * QP + 8 * c) = rq[i]; *(LAS u32x4*)(Ks + j * QP + 8 * c) = rk[i]; }
            float kf[8]; unpack8(rk[i], kf); const float f = gtab[RC - 1 - j];
#pragma unroll
            for (int e = 0; e < 8; ++e) kf[e] *= f;
            *(LAS u32x4*)(Kd + j * KDP + 8 * c) = pack8(kf); }
#pragma unroll
        for (int i = 0; i < 4; ++i) { const int item = tid + 512 * i, j = item >> 5, c = item & 31; *(LAS u32x4*)(Vs + j * VP + 8 * c) = rv[i]; }
        __syncthreads();
        if (ch + 1 < RSEGLEN / RC) gload(ch + 1);
        u32x4 rg[4];
        if (!PRE) { const bf16_t* gp0 = p1 + P1_G + (m0 + (tid >> 3)) * 2048 + h * 256 + 32 * (tid & 7);
#pragma unroll
            for (int q4 = 0; q4 < 2; ++q4) rg[q4] = *(const u32x4*)(gp0 + 8 * q4); }
        f32x16 Ot[2];
        if (!PRE) {
            if (w < 4) {
                const int qi = w >> 1, ji = w & 1; f32x16 sc;
#pragma unroll
                for (int e = 0; e < 16; ++e) sc[e] = 0.f;
                if (qi >= ji) {
#pragma unroll
                    for (int ks = 0; ks < 8; ++ks) { sc = MFMA32(frag_contig(Qs + (32 * qi + r) * QP + 16 * ks + 8 * hh), frag_contig(Ks + (32 * ji + r) * QP + 16 * ks + 8 * hh), sc); if (ks & 1) __builtin_amdgcn_sched_barrier(0); }
                }
#pragma unroll
                for (int e = 0; e < 16; ++e) { const int q = 32 * qi + crow(e, hh), j = 32 * ji + r; const float val = (q >= j) ? sc[e] * gtab[q >= j ? q - j : 0] : 0.f;
                    Ps[q * PP + j] = (bf16_t)(cvtpk(val, 0.f) & 0xffffu); }
            }
#pragma unroll
            for (int qi = 0; qi < 2; ++qi)
#pragma unroll
                for (int e = 0; e < 16; ++e) Ot[qi][e] = 0.f;
#pragma unroll
            for (int i = 0; i < 4; ++i)
#pragma unroll
                for (int s = 0; s < 2; ++s) { const bf16x8 sb = pack_step(St[i], s);
#pragma unroll
                    for (int qi = 0; qi < 2; ++qi) Ot[qi] = MFMA32(frag_perm(Qs + (32 * qi + r) * QP + 32 * i + 16 * s + 4 * hh), sb, Ot[qi]);
                    __builtin_amdgcn_sched_barrier(0); }
#pragma unroll
            for (int qi = 0; qi < 2; ++qi)
#pragma unroll
                for (int e = 0; e < 16; ++e) Ot[qi][e] *= gtab[32 * qi + crow(e, hh) + 1];
            __syncthreads();
#pragma unroll 1
            for (int ks = 0; ks < 4; ++ks) { const bf16x8 vb = frag_tr(Vs, VP, 16 * ks, d0, lane);
#pragma unroll
                for (int qi = 0; qi < 2; ++qi) Ot[qi] = MFMA32(frag_contig(Ps + (32 * qi + r) * PP + 16 * ks + 8 * hh), vb, Ot[qi]); }
        }
#pragma unroll
        for (int i = 0; i < 4; ++i)
#pragma unroll
            for (int e = 0; e < 16; ++e) St[i][e] *= g64;
#pragma unroll 1
        for (int ks = 0; ks < 4; ++ks) { const bf16x8 vb = frag_tr(Vs, VP, 16 * ks, d0, lane);
#pragma unroll
            for (int i = 0; i < 4; ++i) St[i] = MFMA32(frag_tr(Kd, KDP, 16 * ks, 32 * i, lane), vb, St[i]); }
        __syncthreads();
        if (!PRE) {
            __builtin_amdgcn_sched_barrier(0);
#pragma unroll
            for (int qi = 0; qi < 2; ++qi)
#pragma unroll
                for (int e = 0; e < 16; ++e) Os[(32 * qi + crow(e, hh)) * OSP + d0 + r] = Ot[qi][e];
            __syncthreads();
            {
                const int row = tid >> 3, sg = tid & 7; const LAS float* orow = Os + row * OSP + 32 * sg; float s1 = 0.f, s2 = 0.f;
                { const bf16_t* gp0 = p1 + P1_G + (m0 + row) * 2048 + h * 256 + 32 * sg; rg[2] = *(const u32x4*)(gp0 + 16); rg[3] = *(const u32x4*)(gp0 + 24); }
#pragma unroll
                for (int e = 0; e < 32; e += 4) { const f32x4 t4 = *(const LAS f32x4*)(orow + e); s1 += (t4.x + t4.y) + (t4.z + t4.w); s2 += (t4.x * t4.x + t4.y * t4.y) + (t4.z * t4.z + t4.w * t4.w); }
                const float mean = red8(s1) * (1.f / 256.f); const float var = fmaxf(red8(s2) * (1.f / 256.f) - mean * mean, 0.f);
                const float rstd = __builtin_amdgcn_rsqf(var + 1e-6f);
                bf16_t* gp = p1 + P1_G + (m0 + row) * 2048 + h * 256 + 32 * sg; const LAS float* gw = gls + 32 * sg;
#pragma unroll
                for (int q4 = 0; q4 < 4; ++q4) { float gg[8]; unpack8(rg[q4], gg); float o[8];
                    const f32x4 ya = *(const LAS f32x4*)(orow + 8 * q4), yb = *(const LAS f32x4*)(orow + 8 * q4 + 4); const float yv[8] = {ya.x, ya.y, ya.z, ya.w, yb.x, yb.y, yb.z, yb.w};
#pragma unroll
                    for (int e = 0; e < 8; ++e) o[e] = siluf_(gg[e]) * ((yv[e] - mean) * rstd * gw[8 * q4 + e]);
                    *(u32x4*)(gp + 8 * q4) = pack8(o); }
            }
            __syncthreads();
        }
    }
    if (PRE) {
        float* dst = SEG + ((size_t)(bh * 3 + seg) * 8 + w) * 4096 + lane;
#pragma unroll
        for (int i = 0; i < 4; ++i)
#pragma unroll
            for (int e = 0; e < 16; ++e) dst[(i * 16 + e) * 64] = St[i][e];
    }
}


constexpr int RP_BUF = RC * KDP * 2 + RC * VP * 2;
static_assert(512 + 2 * RP_BUF <= RING_BYTES, "retention pre-pass LDS");
DI void ret_pre(const Ctx& C, const bf16_t* p1, float* SEG, int bh, int seg) {
    const int lane = lane_id(), w = C.wave, tid = w * 64 + lane, d0 = 32 * w, h = bh & 7;
    LAS float* gtab = (LAS float*)(C.lds + L_GT);
    const float lg2 = log2f(1.0f - exp2f(-5.0f - (float)h)); const float g64 = exp2f(lg2 * 64.f);
    constexpr int NCHK = RSEGLEN / RC;
    __syncthreads();
    if (tid <= 64) gtab[tid] = exp2f(lg2 * (float)tid);
    __syncthreads();
    f32x16 St[4];
#pragma unroll
    for (int i = 0; i < 4; ++i)
#pragma unroll
        for (int e = 0; e < 16; ++e) St[i][e] = 0.f;
    const size_t tt = (size_t)bh * SEQ + (size_t)seg * RSEGLEN;
    u32x4 rkA[2], rvA[4], rkB[2], rvB[4];
    auto gload = [&](u32x4* rk, u32x4* rv, int c) {
#pragma unroll
        for (int i = 0; i < 2; ++i) rk[i] = *(const u32x4*)(p1 + P1_K + (tt + c * RC) * 128 + (size_t)(tid + 512 * i) * 8);
#pragma unroll
        for (int i = 0; i < 4; ++i) rv[i] = *(const u32x4*)(p1 + P1_V + (tt + c * RC) * 256 + (size_t)(tid + 512 * i) * 8);
    };
    auto stage = [&](const u32x4* rk, const u32x4* rv, int buf) {
        LAS bf16_t* Kd = (LAS bf16_t*)(C.lds + 512 + buf * RP_BUF); LAS bf16_t* Vs = Kd + RC * KDP;
#pragma unroll
        for (int i = 0; i < 2; ++i) { const int item = tid + 512 * i, j = item >> 4, c = item & 15; float kf[8]; unpack8(rk[i], kf); const float f = gtab[RC - 1 - j];
#pragma unroll
            for (int e = 0; e < 8; ++e) kf[e] *= f;
            *(LAS u32x4*)(Kd + j * KDP + 8 * c) = pack8(kf); }
#pragma unroll
        for (int i = 0; i < 4; ++i) { const int item = tid + 512 * i, j = item >> 5, c = item & 31; *(LAS u32x4*)(Vs + j * VP + 8 * c) = rv[i]; }
    };
    auto state = [&](int buf) {
        const LAS bf16_t* Kd = (const LAS bf16_t*)(C.lds + 512 + buf * RP_BUF); const LAS bf16_t* Vs = Kd + RC * KDP;
#pragma unroll
        for (int i = 0; i < 4; ++i)
#pragma unroll
            for (int e = 0; e < 16; ++e) St[i][e] *= g64;
#pragma unroll
        for (int ks = 0; ks < 4; ++ks) { const bf16x8 vb = frag_tr(Vs, VP, 16 * ks, d0, lane);
#pragma unroll
            for (int i = 0; i < 4; ++i) St[i] = MFMA32(frag_tr(Kd, KDP, 16 * ks, 32 * i, lane), vb, St[i]); }
    };
    gload(rkA, rvA, 0); gload(rkB, rvB, 1);
    stage(rkA, rvA, 0); gload(rkA, rvA, 2);
    __syncthreads();
#pragma unroll 1
    for (int c = 0; c < NCHK; c += 2) {
        if (c + 1 < NCHK) { stage(rkB, rvB, 1); if (c + 3 < NCHK) gload(rkB, rvB, c + 3); }
        state(0);
        __syncthreads();
        if (c + 2 < NCHK) { stage(rkA, rvA, 0); if (c + 4 < NCHK) gload(rkA, rvA, c + 4); }
        if (c + 1 < NCHK) state(1);
        __syncthreads();
    }
    float* dst = SEG + ((size_t)(bh * 3 + seg) * 8 + w) * 4096 + lane;
#pragma unroll
    for (int i = 0; i < 4; ++i)
#pragma unroll
        for (int e = 0; e < 16; ++e) dst[(i * 16 + e) * 64] = St[i][e];
}

constexpr int M_GI = 512, M_Q = 1024, M_KD = M_Q + RC * QP * 2, M_V = M_KD + RC * KDP * 2, M_P = M_V + RC * VP * 2, M_O = M_P + RC * PP * 2, MOSP = 264, M_END = M_O + RC * MOSP * 2;
static_assert(M_END <= RING_BYTES, "retention main-pass LDS");
DI void ret_main(const Ctx& C, bf16_t* p1, const float* SEG, const float* gnw, int bh, int seg) {
    const int lane = lane_id(), w = C.wave, tid = w * 64 + lane, r = lane & 31, hh = lane >> 5;
    const int b = bh >> 3, h = bh & 7;
    LAS bf16_t* Qs = (LAS bf16_t*)(C.lds + M_Q); LAS bf16_t* Kd = (LAS bf16_t*)(C.lds + M_KD); LAS bf16_t* Vs = (LAS bf16_t*)(C.lds + M_V);
    LAS bf16_t* Ps = (LAS bf16_t*)(C.lds + M_P); LAS bf16_t* Os = (LAS bf16_t*)(C.lds + M_O);
    LAS float* gtab = (LAS float*)(C.lds + L_GT); LAS float* ginv = (LAS float*)(C.lds + M_GI); LAS float* gls = (LAS float*)(C.lds + RING_BYTES + 1024);
    const float lg2 = log2f(1.0f - exp2f(-5.0f - (float)h)); const float g64 = exp2f(lg2 * 64.f);
    constexpr int NCHK = RSEGLEN / RC;
    __syncthreads();
    if (tid <= 64) gtab[tid] = exp2f(lg2 * (float)tid);
    if (tid < 64) ginv[tid] = exp2f(-lg2 * (float)tid);
    if (tid < 256) gls[tid] = gnw[h * 256 + tid];
    __syncthreads();
    if (w < 4) {
        __builtin_amdgcn_s_setprio(2);
        const int d0 = 64 * w; f32x16 St[4][2];
#pragma unroll
        for (int i = 0; i < 4; ++i)
#pragma unroll
            for (int cj = 0; cj < 2; ++cj)
#pragma unroll
                for (int e = 0; e < 16; ++e) St[i][cj][e] = 0.f;
        for (int sp = 0; sp < seg; ++sp) { const float f = exp2f(lg2 * (float)(RSEGLEN * (seg - 1 - sp)));
#pragma unroll
            for (int cj = 0; cj < 2; ++cj) { const float* src = SEG + ((size_t)(bh * 3 + sp) * 8 + 2 * w + cj) * 4096 + lane;
#pragma unroll
                for (int i = 0; i < 4; ++i)
#pragma unroll
                    for (int e = 0; e < 16; ++e) St[i][cj][e] += f * src[(i * 16 + e) * 64]; } }
        __syncthreads();
#pragma unroll 1
        for (int c = 0; c < NCHK; ++c) {
            { const int qi = w >> 1, ji = w & 1; f32x16 sc;
#pragma unroll
                for (int e = 0; e < 16; ++e) sc[e] = 0.f;
                if (qi >= ji) {
#pragma unroll
                    for (int ks = 0; ks < 8; ++ks) sc = MFMA32(frag_contig(Qs + (32 * qi + r) * QP + 16 * ks + 8 * hh), frag_contig(Kd + (32 * ji + r) * KDP + 16 * ks + 8 * hh), sc);
                }
#pragma unroll
                for (int e = 0; e < 16; ++e) { const int q = 32 * qi + crow(e, hh), j = 32 * ji + r; const float val = (q >= j) ? sc[e] * ginv[63 - q] : 0.f;
                    Ps[q * PP + j] = (bf16_t)(cvtpk(val, 0.f) & 0xffffu); } }
            f32x16 Ot[2][2];
#pragma unroll
            for (int qi = 0; qi < 2; ++qi)
#pragma unroll
                for (int cj = 0; cj < 2; ++cj)
#pragma unroll
                    for (int e = 0; e < 16; ++e) Ot[qi][cj][e] = 0.f;
#pragma unroll
            for (int i = 0; i < 4; ++i)
#pragma unroll
                for (int s_ = 0; s_ < 2; ++s_) { const bf16x8 sb0 = pack_step(St[i][0], s_), sb1 = pack_step(St[i][1], s_);
#pragma unroll
                    for (int qi = 0; qi < 2; ++qi) { const bf16x8 a = frag_perm(Qs + (32 * qi + r) * QP + 32 * i + 16 * s_ + 4 * hh);
                        Ot[qi][0] = MFMA32(a, sb0, Ot[qi][0]); Ot[qi][1] = MFMA32(a, sb1, Ot[qi][1]); } }
#pragma unroll
            for (int qi = 0; qi < 2; ++qi)
#pragma unroll
                for (int e = 0; e < 16; ++e) { const float gq = gtab[32 * qi + crow(e, hh) + 1]; Ot[qi][0][e] *= gq; Ot[qi][1][e] *= gq; }
            __syncthreads();
#pragma unroll
            for (int i = 0; i < 4; ++i)
#pragma unroll
                for (int cj = 0; cj < 2; ++cj)
#pragma unroll
                    for (int e = 0; e < 16; ++e) St[i][cj][e] *= g64;
#pragma unroll 1
            for (int ks = 0; ks < 4; ++ks) { const bf16x8 vb0 = frag_tr(Vs, VP, 16 * ks, d0, lane), vb1 = frag_tr(Vs, VP, 16 * ks, d0 + 32, lane);
#pragma unroll
                for (int qi = 0; qi < 2; ++qi) { const bf16x8 a = frag_contig(Ps + (32 * qi + r) * PP + 16 * ks + 8 * hh); Ot[qi][0] = MFMA32(a, vb0, Ot[qi][0]); Ot[qi][1] = MFMA32(a, vb1, Ot[qi][1]); }
#pragma unroll
                for (int i = 0; i < 4; ++i) { const bf16x8 a = frag_tr(Kd, KDP, 16 * ks, 32 * i, lane); St[i][0] = MFMA32(a, vb0, St[i][0]); St[i][1] = MFMA32(a, vb1, St[i][1]); } }
            __syncthreads();
#pragma unroll
            for (int qi = 0; qi < 2; ++qi)
#pragma unroll
                for (int cj = 0; cj < 2; ++cj)
#pragma unroll
                    for (int e = 0; e < 16; ++e) Os[(32 * qi + crow(e, hh)) * MOSP + d0 + 32 * cj + r] = (bf16_t)(cvtpk(Ot[qi][cj][e], 0.f) & 0xffffu);
            __syncthreads();
        }
        __builtin_amdgcn_s_setprio(0);
        __syncthreads();
    } else {
        const int st = tid - 256; const size_t tt = (size_t)bh * SEQ + (size_t)seg * RSEGLEN;
        const size_t m00 = (size_t)b * SEQ + (size_t)seg * RSEGLEN;
        u32x4 rq[4], rk[4], rvA[8], rvB[8], rg[8];
        auto gload = [&](int c) {
#pragma unroll
            for (int i = 0; i < 4; ++i) { const size_t it = (size_t)(st + 256 * i) * 8; rq[i] = *(const u32x4*)(p1 + P1_Q + (tt + c * RC) * 128 + it); rk[i] = *(const u32x4*)(p1 + P1_K + (tt + c * RC) * 128 + it); }
        };
        auto vload = [&](u32x4* rv, int c) {
#pragma unroll
            for (int i = 0; i < 8; ++i) rv[i] = *(const u32x4*)(p1 + P1_V + (tt + c * RC) * 256 + (size_t)(st + 256 * i) * 8);
        };
        auto stage = [&](const u32x4* rv) {
#pragma unroll
            for (int i = 0; i < 4; ++i) { const int item = st + 256 * i, j = item >> 4, cc = item & 15;
                *(LAS u32x4*)(Qs + j * QP + 8 * cc) = rq[i];
                float kf[8]; unpack8(rk[i], kf); const float f = gtab[RC - 1 - j];
#pragma unroll
                for (int e = 0; e < 8; ++e) kf[e] *= f;
                *(LAS u32x4*)(Kd + j * KDP + 8 * cc) = pack8(kf); }
#pragma unroll
            for (int i = 0; i < 8; ++i) { const int item = st + 256 * i, j = item >> 5, cc = item & 31; *(LAS u32x4*)(Vs + j * VP + 8 * cc) = rv[i]; }
        };
        const int row = st >> 2, sq = st & 3;
        auto gate_load = [&](int c) { const bf16_t* gp0 = p1 + P1_G + (m00 + c * RC + row) * 2048 + h * 256 + 64 * sq;
#pragma unroll
            for (int q8 = 0; q8 < 8; ++q8) rg[q8] = *(const u32x4*)(gp0 + 8 * q8); };
        float mean = 0.f, rstd = 0.f;
        auto epi_stats = [&]() { const LAS bf16_t* orow = Os + row * MOSP + 64 * sq; float s1 = 0.f, s2 = 0.f;
#pragma unroll
            for (int q8 = 0; q8 < 8; ++q8) { float t[8]; unpack8(*(const LAS u32x4*)(orow + 8 * q8), t);
#pragma unroll
                for (int k = 0; k < 8; ++k) { s1 += t[k]; s2 += t[k] * t[k]; } }
            s1 += dppmov<0xB1>(s1); s1 += dppmov<0x4E>(s1); s2 += dppmov<0xB1>(s2); s2 += dppmov<0x4E>(s2);
            mean = s1 * (1.f / 256.f); const float var = fmaxf(s2 * (1.f / 256.f) - mean * mean, 0.f); rstd = __builtin_amdgcn_rsqf(var + 1e-6f); };
        auto epi_out = [&](int c, int q0) { const LAS bf16_t* orow = Os + row * MOSP + 64 * sq; const LAS float* gw = gls + 64 * sq;
            bf16_t* gp = p1 + P1_G + (m00 + c * RC + row) * 2048 + h * 256 + 64 * sq;
#pragma unroll
            for (int q8 = q0; q8 < q0 + 4; ++q8) { float gg[8], yv[8], o[8]; unpack8(rg[q8], gg); unpack8(*(const LAS u32x4*)(orow + 8 * q8), yv);
                const f32x4 wa = *(const LAS f32x4*)(gw + 8 * q8), wb = *(const LAS f32x4*)(gw + 8 * q8 + 4); const float wv[8] = {wa.x, wa.y, wa.z, wa.w, wb.x, wb.y, wb.z, wb.w};
#pragma unroll
                for (int e = 0; e < 8; ++e) o[e] = siluf_(gg[e]) * ((yv[e] - mean) * (rstd * wv[e]));
                *(u32x4*)(gp + 8 * q8) = pack8(o); } };
        gload(0); vload(rvA, 0); vload(rvB, 1); stage(rvA); gload(1); vload(rvA, 2);
        __syncthreads();
#pragma unroll 1
        for (int c = 0; c < NCHK; c += 2) {
            if (c > 0) { epi_stats(); epi_out(c - 1, 0); }
            __syncthreads();
            if (c > 0) epi_out(c - 1, 4);
            __syncthreads();
            stage(rvB); if (c + 2 < NCHK) gload(c + 2); if (c + 3 < NCHK) vload(rvB, c + 3);
            gate_load(c);
            __syncthreads();
            epi_stats(); epi_out(c, 0);
            __syncthreads();
            epi_out(c, 4);
            __syncthreads();
            if (c + 2 < NCHK) { stage(rvA); if (c + 3 < NCHK) gload(c + 3); if (c + 4 < NCHK) vload(rvA, c + 4); }
            gate_load(c + 1);
            __syncthreads();
        }
        epi_stats(); epi_out(NCHK - 1, 0); epi_out(NCHK - 1, 4);
        __syncthreads();
    }
}

constexpr int NPHASE = 19;
struct Args { const float* in[27]; float* out; unsigned char* ws; int ph_lo, ph_hi; };
__global__ void __launch_bounds__(512, 2) fwd_kernel(Args args) {
    extern __shared__ __attribute__((aligned(16))) unsigned char lds_raw[];
    Ctx C; C.lds = (LAS unsigned char*)lds_raw; C.wave = __builtin_amdgcn_readfirstlane((int)threadIdx.x >> 6);
    C.G = gridDim.x; { const int bx = blockIdx.x; C.vcu = (C.G % 8 == 0) ? (bx % 8) * (C.G / 8) + bx / 8 : bx; }
    unsigned char* ws = args.ws; const float* const* in = args.in;
    volatile LAS unsigned* MISC = (volatile LAS unsigned*)(C.lds + MISC_OFF);
    for (int u = (int)threadIdx.x; u < (LDS_BYTES - RING_BYTES) / 4; u += 512) ((LAS unsigned*)(C.lds + RING_BYTES))[u] = 0u;
    __syncthreads();
#if MK_PER_PHASE
#define GRID_BAR() do { } while (0)
#else
    XcdBarrier bar = xcd_barrier_post((unsigned*)(ws + WS_CTL) + 1024, MISC + 8);
#define GRID_BAR() xcd_barrier(bar)
#endif
    const int lo = args.ph_lo, hi = args.ph_hi;
#ifndef PH_MASK
#define PH_MASK 0x7ffff
#endif
#define IN(k) (((PH_MASK >> (k)) & 1) && lo <= (k) && (k) < hi)
#define SEAM(k) do { if (IN(k) && IN((k) + 1)) GRID_BAR(); } while (0)
    bf16_t* U = (bf16_t*)(ws + R_U);
    bf16_t* HB = (bf16_t*)(ws + WS_HB); float* RS = (float*)(ws + WS_RS);
    float* H = args.out;
    const int bx = (int)blockIdx.x;

    if (IN(0)) { p_prologue(C, in, ws); } SEAM(0);
    if (IN(1)) { pg8::Gemm g{U, (const bf16_t*)(ws + W_IN0), MTOK, AB_PAD, DM, DM}; pg8::StaticOrder S; S.init(MTOK, AB_PAD, C.G, bx);
        pg8::Epi<FStoreRs> E{{(bf16_t*)(ws + R_A), AB_PAD, RS}}; pg8::gemm_phase<false>(C.lds, C.wave, g, S, E); } SEAM(1);
    if (IN(2)) { p_lora_pre(C, (const bf16_t*)(ws + R_A), in[12], (bf16_t*)(ws + WS_AP)); } SEAM(2);
    if (IN(3)) { pg8::Gemm g{(const bf16_t*)(ws + WS_AP), (const bf16_t*)(ws + W_LORA), MTOK, 1536, 256, 256}; pg8::StaticOrder S; S.init(MTOK, 1536, C.G, bx);
        pg8::Epi<FLora> E{{(bf16_t*)(ws + WS_LW), (bf16_t*)(ws + WS_AA), (bf16_t*)(ws + WS_GT), in[13], in[15]}}; pg8::gemm_phase<false>(C.lds, C.wave, g, S, E); } SEAM(3);
    ScanArgs SA{(const bf16_t*)(ws + R_A), U, (bf16_t*)(ws + WS_AP), in[8], in[9], in[10], in[11], in[12], in[18], in[19], in[20], in[21], in[22], (const bf16_t*)(ws + WS_LW), (const bf16_t*)(ws + WS_AA), (const bf16_t*)(ws + WS_GT)};
    if (IN(4)) {
        for (int task = bx; task < 256; task += C.G) { const int bh = (task >> 1) & 63, half = task >> 7;
            if (task & 1) chunk_task<true>(C, SA, bh >> 3, bh & 7, half); else chunk_task<false>(C, SA, bh >> 3, bh & 7, half);
            __syncthreads();
            const int nsl = (task & 1) ? WT_RW : WT_GD, g0 = ((task >> 1) * 8 + C.wave) * (WT_RW + WT_GD) + ((task & 1) ? 0 : WT_RW);
#pragma unroll 1
            for (int sl = 0; sl < nsl; ++sl) p_weights(C, in, ws, 1, 8, true, g0 + sl, 128 * 8 * (WT_RW + WT_GD));
            __syncthreads(); }
    } SEAM(4);
    if (IN(18)) { p_mix_post(C, SA); } if (IN(18) && IN(5)) GRID_BAR();
    if (IN(5)) { pg8::Gemm g{U, (const bf16_t*)(ws + W_OUT0), MTOK, DM, DM, DM}; pg8::StaticOrder S; S.init(MTOK, DM, C.G, bx);
        pg8::Epi<FStore> E{{(bf16_t*)(ws + R_B), DM}}; pg8::gemm_phase<false>(C.lds, C.wave, g, S, E); } SEAM(5);
    constexpr bool QUP0 = (Q8_MASK >> 2) & 1, QUP1 = (Q8_MASK >> 6) & 1;
    if (IN(6)) { p_norm(C, in[0], nullptr, (const bf16_t*)(ws + R_B), in[2], HB, nullptr, RS, QUP0 ? (signed char*)(ws + R_U) : nullptr); } SEAM(6);
    if (IN(7)) { pg8::StaticOrder S; S.init(MTOK, FF, C.G, bx);
        if (QUP0) { pg8::Gemm g{(const bf16_t*)(ws + R_U), (const bf16_t*)(ws + W_UP0), MTOK, FF, DM / 2, DM / 2}; pg8::Epi<FRelu2> E{{(bf16_t*)(ws + R_A), FF, RS, (const float*)(ws + WS_SW) + 1 * 6144}}; pg8::gemm_phase<true>(C.lds, C.wave, g, S, E); }
        else { pg8::Gemm g{HB, (const bf16_t*)(ws + W_UP0), MTOK, FF, DM, DM}; pg8::Epi<FRelu2> E{{(bf16_t*)(ws + R_A), FF, RS, nullptr}}; pg8::gemm_phase<false>(C.lds, C.wave, g, S, E); } } SEAM(7);
    if (IN(8)) { pg8::Gemm g{(const bf16_t*)(ws + R_A), (const bf16_t*)(ws + W_DN0), MTOK, DM, FF, FF}; pg8::StaticOrder S; S.init(MTOK, DM, C.G, bx);
        pg8::Epi<FStore> E{{(bf16_t*)(ws + R_B), DM}}; pg8::gemm_phase<false>(C.lds, C.wave, g, S, E); } SEAM(8);
    if (IN(9)) { p_norm(C, nullptr, HB, (const bf16_t*)(ws + R_B), in[4], HB, nullptr, RS, (signed char*)H); } SEAM(9);
    bf16_t* P1 = (bf16_t*)(ws + R_U);
    float* SEGP = (float*)H; bf16_t* MIX1 = (bf16_t*)((unsigned char*)H + 64 * MiB);
    if (IN(10)) { pg8::Gemm g{(const bf16_t*)H, (const bf16_t*)(ws + W_IN1), MTOK, RET_IN, DM / 2, DM / 2}; pg8::StaticOrder S; S.init(MTOK, RET_IN, C.G, bx);
        pg8::Epi<FRotary> E{{P1, (const f32x2*)(ws + WS_ROT), RS, (const float*)(ws + WS_SW) + 2 * 6144}}; pg8::gemm_phase<true>(C.lds, C.wave, g, S, E); } SEAM(10);
    if (IN(11)) { for (int unit = bx; unit < 256; unit += C.G) { const int bh = unit >> 2, seg = unit & 3; if (seg < 3) ret_pre(C, P1, SEGP, bh, seg); } } SEAM(11);
    if (IN(12)) { for (int unit = bx; unit < 256; unit += C.G) { const int bh = unit >> 2, seg = unit & 3; ret_main(C, P1, SEGP, in[25], bh, seg); } } SEAM(12);
    if (IN(13)) { pg8::Gemm g{P1 + P1_G, (const bf16_t*)(ws + W_OUT1), MTOK, DM, 2048, 2048}; pg8::StaticOrder S; S.init(MTOK, DM, C.G, bx);
        pg8::Epi<FStore> E{{MIX1, DM}}; pg8::gemm_phase<false>(C.lds, C.wave, g, S, E); } SEAM(13);
    if (IN(14)) { p_norm(C, nullptr, HB, MIX1, in[2] + DM, HB, nullptr, RS, QUP1 ? (signed char*)(ws + 384 * MiB) : nullptr); } SEAM(14);
    if (IN(15)) { pg8::StaticOrder S; S.init(MTOK, FF, C.G, bx);
        if (QUP1) { pg8::Gemm g{(const bf16_t*)(ws + 384 * MiB), (const bf16_t*)(ws + W_UP1), MTOK, FF, DM / 2, DM / 2}; pg8::Epi<FRelu2> E{{(bf16_t*)(ws + 64 * MiB), FF, RS, (const float*)(ws + WS_SW) + 3 * 6144}}; pg8::gemm_phase<true>(C.lds, C.wave, g, S, E); }
        else { pg8::Gemm g{HB, (const bf16_t*)(ws + W_UP1), MTOK, FF, DM, DM}; pg8::Epi<FRelu2> E{{(bf16_t*)(ws + 64 * MiB), FF, RS, nullptr}}; pg8::gemm_phase<false>(C.lds, C.wave, g, S, E); } } SEAM(15);
    if (IN(16)) { pg8::Gemm g{(const bf16_t*)(ws + 64 * MiB), (const bf16_t*)(ws + W_DN1), MTOK, DM, FF, FF}; pg8::StaticOrder S; S.init(MTOK, DM, C.G, bx);
        pg8::Epi<FStore> E{{(bf16_t*)(ws + 320 * MiB), DM}}; pg8::gemm_phase<false>(C.lds, C.wave, g, S, E); } SEAM(16);
    if (IN(17)) { p_norm(C, nullptr, HB, (const bf16_t*)(ws + 320 * MiB), in[4] + DM, nullptr, H, nullptr); }
#undef IN
#undef SEAM
}

extern "C" void kernel_launch(void* const* d_in, const int* in_sizes, int n_in, void* d_out, int out_size, void* d_ws, size_t ws_size, hipStream_t stream) {
    static int grid = 0;
    if (grid == 0) {
        if (n_in != 27 || out_size != MTOK * DM || ws_size < WS_END) { fprintf(stderr, "kernel_launch: unexpected shapes (n_in %d out %d ws %zu)\n", n_in, out_size, ws_size); grid = -1; return; }
        int dev = 0, cus = 0;
        if (hipGetDevice(&dev) != hipSuccess || hipDeviceGetAttribute(&cus, hipDeviceAttributeMultiprocessorCount, dev) != hipSuccess) { grid = -1; return; }
        if (hipFuncSetAttribute((const void*)fwd_kernel, hipFuncAttributeMaxDynamicSharedMemorySize, LDS_BYTES) != hipSuccess) { fprintf(stderr, "kernel_launch: hipFuncSetAttribute failed\n"); grid = -1; return; }
        int per_cu = 0;
        if (hipOccupancyMaxActiveBlocksPerMultiprocessor(&per_cu, (const void*)fwd_kernel, 512, LDS_BYTES) != hipSuccess || per_cu < 1) { fprintf(stderr, "kernel_launch: occupancy query says %d blocks per CU; nothing launched\n", per_cu); grid = -1; return; }
        (void)hipGetLastError();
        grid = cus;
    }
    if (grid < 0) return;
    (void)hipMemsetAsync((char*)d_ws + WS_CTL, 0, CTL_ZERO_BYTES, stream);
    Args a{};
    for (int i = 0; i < 27; ++i) a.in[i] = (const float*)d_in[i];
    a.out = (float*)d_out; a.ws = (unsigned char*)d_ws;
#if MK_PER_PHASE
    const int order[NPHASE] = {0, 1, 2, 3, 4, 18, 5, 6, 7, 8, 9, 10, 11, 12, 13, 14, 15, 16, 17};
    for (int q = 0; q < NPHASE; ++q) { const int p = order[q]; a.ph_lo = p; a.ph_hi = p + 1; hipLaunchKernelGGL(fwd_kernel, dim3(grid), dim3(512), LDS_BYTES, stream, a); }
#else
    a.ph_lo = 0; a.ph_hi = NPHASE; hipLaunchKernelGGL(fwd_kernel, dim3(grid), dim3(512), LDS_BYTES, stream, a);
#endif
}
```

```cpp
#include <hip/hip_runtime.h>
#include <cstdio>
#include <cstdint>

#ifndef MK_PER_PHASE
#define MK_PER_PHASE 0
#endif

#define LAS __attribute__((address_space(3)))
typedef unsigned short bf16_t;
typedef short bf16x8 __attribute__((ext_vector_type(8)));
typedef short s16x4 __attribute__((ext_vector_type(4)));
typedef float f32x4 __attribute__((ext_vector_type(4)));
typedef float f32x2 __attribute__((ext_vector_type(2)));
typedef float f32x16 __attribute__((ext_vector_type(16)));
typedef unsigned u32x4 __attribute__((ext_vector_type(4)));
typedef unsigned u32x2 __attribute__((ext_vector_type(2)));
typedef __bf16 bf16x2_t __attribute__((ext_vector_type(2)));

#define DI __device__ __forceinline__

DI unsigned cvtpk(float lo, float hi) { f32x2 v = {lo, hi}; bf16x2_t b = __builtin_convertvector(v, bf16x2_t); return __builtin_bit_cast(unsigned, b); }
DI float bflo(unsigned w) { return __uint_as_float(w << 16); }
DI float bfhi(unsigned w) { return __uint_as_float(w & 0xffff0000u); }
DI float bf1(bf16_t h) { return __uint_as_float(((unsigned)h) << 16); }
DI void unpack8(const u32x4 w, float* f) { f[0] = bflo(w.x); f[1] = bfhi(w.x); f[2] = bflo(w.y); f[3] = bfhi(w.y); f[4] = bflo(w.z); f[5] = bfhi(w.z); f[6] = bflo(w.w); f[7] = bfhi(w.w); }
DI u32x4 pack8(const float* f) { u32x4 w; w.x = cvtpk(f[0], f[1]); w.y = cvtpk(f[2], f[3]); w.z = cvtpk(f[4], f[5]); w.w = cvtpk(f[6], f[7]); return w; }
DI float sigmoidf_(float x) { return __builtin_amdgcn_rcpf(1.0f + __expf(-x)); }
DI float siluf_(float x) { return x * __builtin_amdgcn_rcpf(1.0f + __expf(-x)); }
DI float softplusf_(float x) { return fmaxf(x, 0.f) + __logf(1.0f + __expf(-fabsf(x))); }

constexpr int BATCH = 8, SEQ = 4096, DM = 1024, MTOK = BATCH * SEQ;
constexpr int FF = 4096;
constexpr int AB_IN = 3856, AB_PAD = 4096;
constexpr int RP0 = 2064;
constexpr int RET_IN = 6144;
constexpr float RMS_EPS = 1e-6f;

namespace pg8 {
constexpr int BM = 256, BK = 64, HALF = 128, HTB = HALF * BK * 2, STAGE_BYTES = 8 * HTB, NXCD = 8, WGM = 8;
__host__ __device__ __forceinline__ int lds_byte(int r, int c) { const int st = (r >> 4) * 2 + (c >> 5), rr = r & 15, cc = c & 31, ob = rr * 64 + cc * 2; return st * 1024 + (ob ^ (((ob >> 9) & 1) << 5)); }
__host__ __device__ __forceinline__ void stage_rc(int b, int& R, int& C) { const int st = b / 1024, sb = b % 1024, swz = sb ^ (((sb >> 9) & 1) << 5); R = (st >> 1) * 16 + swz / 64; C = (st & 1) * 32 + (swz % 64) / 2; }
__host__ __device__ __forceinline__ int perm32(int rho) { const int n = rho >> 4, i = rho & 15; return 8 * (i >> 2) + 4 * n + (i & 3); }
struct Unit { int pm, pn; };
struct Gemm { const bf16_t* A; const bf16_t* Bt; int M, N, K, lda; };
struct StaticOrder {
    int nM, nN, nwg, G, c, rev;
    __device__ void init(int M, int N, int G_, int c_, int rev_ = 0) { nM = M / BM; nN = N / BM; nwg = nM * nN; G = G_; c = c_; rev = rev_; }
    __device__ bool next(int i, Unit& u) const {
        const long L = (long)i * G + c; if (L >= nwg) return false;
        int wgid = (int)L; { const int q = nwg / NXCD, r = nwg % NXCD, xcd = wgid % NXCD, off = wgid / NXCD; wgid = (xcd < r ? xcd * (q + 1) : r * (q + 1) + (xcd - r) * q) + off; }
        const int nig = WGM * nN, gid = wgid / nig, fm = gid * WGM, gsz = (nM - fm) < WGM ? (nM - fm) : WGM;
        u.pm = fm + ((wgid % nig) % gsz); u.pn = (wgid % nig) / gsz; if (rev) u.pm = nM - 1 - u.pm; return true;
    }
};
template <class F> struct Epi {
    F f;
    __device__ __forceinline__ void operator()(const f32x4 (&acc)[2][2][4][2], const Unit& u, int wr, int wc, int fr, int fq) const {
        const int row0 = u.pm * BM + wr * 64 + fr, col0 = u.pn * BM + wc * 32 + 8 * fq;
        typename F::Pre pre; f.prepare(pre, row0, col0);
#pragma unroll
        for (int ai = 0; ai < 2; ++ai) {
            f.batch(pre, row0 + ai * HALF, col0);
            __builtin_amdgcn_sched_barrier(0);
#pragma unroll
            for (int m = 0; m < 4; ++m)
#pragma unroll
                for (int bj = 0; bj < 2; ++bj) {
                    const f32x4 v0 = acc[ai][bj][m][0], v1 = acc[ai][bj][m][1];
                    float v[8] = {v0[0], v0[1], v0[2], v0[3], v1[0], v1[1], v1[2], v1[3]};
                    f(row0 + ai * HALF + m * 16, col0 + bj * HALF, v, ai * 4 + m, m, bj, pre);
                }
        }
    }
};

typedef int i32x4 __attribute__((ext_vector_type(4)));
template <bool I8> __device__ __forceinline__ f32x4 mma16(const bf16x8 b, const bf16x8 a, const f32x4 c) {
    if constexpr (I8) return __builtin_bit_cast(f32x4, __builtin_amdgcn_mfma_i32_16x16x64_i8(__builtin_bit_cast(i32x4, b), __builtin_bit_cast(i32x4, a), __builtin_bit_cast(i32x4, c), 0, 0, 0));
    else return __builtin_amdgcn_mfma_f32_16x16x32_bf16(b, a, c, 0, 0, 0);
}
template <bool I8, class EpiT>
__device__ __forceinline__ void gemm_phase(LAS unsigned char* lds, int wid, const Gemm g, const StaticOrder& S, const EpiT& E) {
    const int lane = (int)__builtin_amdgcn_mbcnt_hi(~0u, __builtin_amdgcn_mbcnt_lo(~0u, 0u)), tid = wid * 64 + lane, wr = wid >> 2, wc = wid & 3, fr = lane & 15, fq = lane >> 4;
    const int K = g.K, nt = K / BK, lda = g.lda;
    unsigned voffA[2], voffB[2];
#pragma unroll
    for (int i = 0; i < 2; ++i) { int R, C; stage_rc(tid * 16 + i * 8192, R, C); const int Rb = (R & ~31) + perm32(R & 31);
        voffA[i] = (unsigned)(R * lda + C) * 2u; voffB[i] = (unsigned)(Rb * K + C) * 2u; }
    const size_t kstep = (size_t)(BK * 2);
    const size_t hstepA = (size_t)HALF * lda * 2, hstepB = (size_t)HALF * K * 2;
    const size_t tstepA = 2 * hstepA, tstepB = 2 * hstepB;
    const unsigned ldsw = (unsigned)wid * 1024u;
    const int aoff = lds_byte(wr * 64 + fr, fq * 8), boff = lds_byte(wc * 32 + fr, fq * 8);
#define PG8_SA(b, h) (((b) * 2 + (h)) * HTB)
#define PG8_SB(b, h) ((4 + (b) * 2 + (h)) * HTB)
#define PG8_STAGE(bufoff, gbase, voff) do { _Pragma("unroll") for (int _i = 0; _i < 2; ++_i) \
        __builtin_amdgcn_global_load_lds((const unsigned*)((const char*)(gbase) + (voff)[_i]), (LAS unsigned*)(lds + (bufoff) + ldsw + _i * 8192), 16, 0, 0); } while (0)
#define PG8_LDA(dst, b, h) do { _Pragma("unroll") for (int m = 0; m < 4; ++m) _Pragma("unroll") for (int k = 0; k < 2; ++k) dst[m][k] = *(const LAS bf16x8*)(lds + PG8_SA(b, h) + aoff + m * 2048 + k * 1024); } while (0)
#define PG8_LDB(dst, b, h) do { _Pragma("unroll") for (int n = 0; n < 2; ++n) _Pragma("unroll") for (int k = 0; k < 2; ++k) dst[n][k] = *(const LAS bf16x8*)(lds + PG8_SB(b, h) + boff + n * 2048 + k * 1024); } while (0)
#define PG8_MMA(ai, bj, At, Bt) do { __builtin_amdgcn_s_setprio(1); _Pragma("unroll") for (int m = 0; m < 4; ++m) _Pragma("unroll") for (int n = 0; n < 2; ++n) _Pragma("unroll") for (int k = 0; k < 2; ++k) \
        acc[ai][bj][m][n] = mma16<I8>(Bt[n][k], At[m][k], acc[ai][bj][m][n]); __builtin_amdgcn_s_setprio(0); } while (0)
#define PG8_WAIT_V(n) asm volatile("s_waitcnt vmcnt(" #n ")" ::: "memory")
#define PG8_WAIT_L(n) asm volatile("s_waitcnt lgkmcnt(" #n ")" ::: "memory")
#define PG8_BAR __builtin_amdgcn_s_barrier()
#define PG8_SCHED __builtin_amdgcn_sched_barrier(0)
    Unit cur, nxt; int ui = 0;
    if (!S.next(0, cur)) return;
    f32x4 acc[2][2][4][2];
#pragma unroll
    for (int a = 0; a < 2; ++a)
#pragma unroll
        for (int b = 0; b < 2; ++b)
#pragma unroll
            for (int m = 0; m < 4; ++m)
#pragma unroll
                for (int n = 0; n < 2; ++n) acc[a][b][m][n] = (f32x4){0.f, 0.f, 0.f, 0.f};
    bf16x8 At[4][2], B0[2][2], B1[2][2];
    const char* cA = (const char*)g.A + (size_t)cur.pm * tstepA; const char* cB = (const char*)g.Bt + (size_t)cur.pn * tstepB;
    PG8_STAGE(PG8_SB(0, 0), cB, voffB); PG8_STAGE(PG8_SB(0, 1), cB + hstepB, voffB); PG8_STAGE(PG8_SA(0, 0), cA, voffA); PG8_STAGE(PG8_SA(0, 1), cA + hstepA, voffA);
    if (wr == 1) PG8_BAR;
    PG8_WAIT_V(2); PG8_BAR;
    PG8_STAGE(PG8_SB(1, 0), cB + kstep, voffB); PG8_STAGE(PG8_SA(1, 0), cA + kstep, voffA); PG8_STAGE(PG8_SB(1, 1), cB + hstepB + kstep, voffB);
    PG8_WAIT_V(6); PG8_BAR;
    for (;;) {
        const bool has_next = S.next(ui + 1, nxt);
        const char* nA = has_next ? (const char*)g.A + (size_t)nxt.pm * tstepA : cA; const char* nB = has_next ? (const char*)g.Bt + (size_t)nxt.pn * tstepB : cB;
        for (int t = 0; t < nt; t += 2) {
            const bool last = (t == nt - 2);
            const char* a1 = cA + (size_t)(t + 1) * kstep;
            const char* a2 = last ? nA : cA + (size_t)(t + 2) * kstep; const char* b2 = last ? nB : cB + (size_t)(t + 2) * kstep;
            const char* a3 = a2 + kstep; const char* b3 = b2 + kstep;
            PG8_LDB(B0, 0, 0); PG8_LDB(B1, 0, 1); PG8_SCHED; PG8_LDA(At, 0, 0); PG8_STAGE(PG8_SA(1, 1), a1 + hstepA, voffA);
            PG8_WAIT_V(8); PG8_WAIT_L(0); PG8_BAR; PG8_MMA(0, 0, At, B0); PG8_MMA(0, 1, At, B1); PG8_BAR; PG8_SCHED;
            PG8_LDA(At, 0, 1); PG8_STAGE(PG8_SB(0, 0), b2, voffB); PG8_STAGE(PG8_SB(0, 1), b2 + hstepB, voffB); PG8_STAGE(PG8_SA(0, 0), a2, voffA);
            PG8_WAIT_V(8); PG8_WAIT_L(0); PG8_BAR; PG8_MMA(1, 0, At, B0); PG8_MMA(1, 1, At, B1); PG8_BAR; PG8_SCHED;
            PG8_LDB(B0, 1, 0); PG8_LDB(B1, 1, 1); PG8_SCHED; PG8_LDA(At, 1, 0); PG8_STAGE(PG8_SA(0, 1), a2 + hstepA, voffA);
            PG8_WAIT_V(8); PG8_WAIT_L(0); PG8_BAR; PG8_MMA(0, 0, At, B0); PG8_MMA(0, 1, At, B1); PG8_BAR; PG8_SCHED;
            PG8_LDA(At, 1, 1); PG8_STAGE(PG8_SB(1, 0), b3, voffB); PG8_STAGE(PG8_SB(1, 1), b3 + hstepB, voffB); PG8_STAGE(PG8_SA(1, 0), a3, voffA);
            PG8_WAIT_V(8); PG8_WAIT_L(0); PG8_BAR; PG8_MMA(1, 0, At, B0); PG8_MMA(1, 1, At, B1); PG8_BAR; PG8_SCHED;
        }
        if (wr == 0) PG8_BAR;
        if constexpr (I8) {
#pragma unroll
            for (int a = 0; a < 2; ++a)
#pragma unroll
                for (int b = 0; b < 2; ++b)
#pragma unroll
                    for (int m = 0; m < 4; ++m)
#pragma unroll
                        for (int n = 0; n < 2; ++n) { const i32x4 iv = __builtin_bit_cast(i32x4, acc[a][b][m][n]); acc[a][b][m][n] = (f32x4){(float)iv[0], (float)iv[1], (float)iv[2], (float)iv[3]}; }
        }
        E(acc, cur, wr, wc, fr, fq);
        if (!has_next) break;
#pragma unroll
        for (int a = 0; a < 2; ++a)
#pragma unroll
            for (int b = 0; b < 2; ++b)
#pragma unroll
                for (int m = 0; m < 4; ++m)
#pragma unroll
                    for (int n = 0; n < 2; ++n) acc[a][b][m][n] = (f32x4){0.f, 0.f, 0.f, 0.f};
        cur = nxt; cA = nA; cB = nB; ++ui;
        if (wr == 1) PG8_BAR;
    }
    PG8_WAIT_V(0);
    PG8_BAR;
#undef PG8_SA
#undef PG8_SB
#undef PG8_STAGE
#undef PG8_LDA
#undef PG8_LDB
#undef PG8_MMA
#undef PG8_WAIT_V
#undef PG8_WAIT_L
#undef PG8_BAR
#undef PG8_SCHED
}
}

struct PreNone {};
struct FStore { bf16_t* O; int ldc; typedef PreNone Pre;
    DI void prepare(Pre&, int, int) const {} DI void batch(Pre&, int, int) const {}
    DI void operator()(int row, int col, const float* v, int, int, int, const Pre&) const { *(u32x4*)(O + (size_t)row * ldc + col) = pack8(v); } };
struct PreRs { float rs[8]; };
struct FStoreRs { bf16_t* O; int ldc; const float* rs; typedef PreRs Pre;
    DI void prepare(Pre& p, int row0, int) const {
#pragma unroll
        for (int q = 0; q < 8; ++q) p.rs[q] = rs[row0 + (q >> 2) * 128 + (q & 3) * 16]; }
    DI void batch(Pre&, int, int) const {}
    DI void operator()(int row, int col, const float* v, int ri, int, int, const Pre& p) const { const float s = p.rs[ri]; float w[8];
#pragma unroll
        for (int e = 0; e < 8; ++e) w[e] = v[e] * s;
        *(u32x4*)(O + (size_t)row * ldc + col) = pack8(w); } };
struct PreRsSw { float rs[8]; f32x4 sw[2][2]; };
struct FRelu2 { bf16_t* O; int ldc; const float* rs; const float* sw; typedef PreRsSw Pre;
    DI void prepare(Pre& p, int row0, int col0) const {
#pragma unroll
        for (int q = 0; q < 8; ++q) p.rs[q] = rs[row0 + (q >> 2) * 128 + (q & 3) * 16];
#pragma unroll
        for (int bj = 0; bj < 2; ++bj) { if (sw) { p.sw[bj][0] = *(const f32x4*)(sw + col0 + bj * 128); p.sw[bj][1] = *(const f32x4*)(sw + col0 + bj * 128 + 4); } else { p.sw[bj][0] = (f32x4){1.f, 1.f, 1.f, 1.f}; p.sw[bj][1] = (f32x4){1.f, 1.f, 1.f, 1.f}; } } }
    DI void batch(Pre&, int, int) const {}
    DI void operator()(int row, int col, const float* v, int ri, int, int bj, const Pre& p) const { float w[8]; const float s = p.rs[ri];
        const float cs8[8] = {p.sw[bj][0].x, p.sw[bj][0].y, p.sw[bj][0].z, p.sw[bj][0].w, p.sw[bj][1].x, p.sw[bj][1].y, p.sw[bj][1].z, p.sw[bj][1].w};
#pragma unroll
        for (int e = 0; e < 8; ++e) { const float r = fmaxf(v[e] * s * cs8[e], 0.f); w[e] = r * r; }
        *(u32x4*)(O + (size_t)row * ldc + col) = pack8(w); } };
struct PreRot { float rs[8]; f32x4 sw[2][2]; f32x2 rot[4][4]; };
constexpr size_t P1_Q = 0, P1_K = (size_t)32768 * 1024, P1_V = 2 * P1_K, P1_G = P1_V + (size_t)32768 * 2048;
struct FRotary { bf16_t* O; const f32x2* rot; const float* rs; const float* sw; typedef PreRot Pre;
    DI void prepare(Pre& p, int row0, int col0) const {
#pragma unroll
        for (int q = 0; q < 8; ++q) p.rs[q] = rs[row0 + (q >> 2) * 128 + (q & 3) * 16];
#pragma unroll
        for (int bj = 0; bj < 2; ++bj) { p.sw[bj][0] = *(const f32x4*)(sw + col0 + bj * 128); p.sw[bj][1] = *(const f32x4*)(sw + col0 + bj * 128 + 4); } }
    DI void batch(Pre& p, int rowb, int col0) const {
        if (col0 < 2048) { const int i0 = (col0 & 127) >> 1;
#pragma unroll
            for (int m = 0; m < 4; ++m) { const int pos = (rowb + m * 16) & (SEQ - 1);
#pragma unroll
                for (int q = 0; q < 4; ++q) p.rot[m][q] = rot[pos * 64 + i0 + q]; } } }
    DI void operator()(int row, int col, const float* v0, int ri, int m, int bj, const Pre& p) const { float w[8], v[8]; const float s = p.rs[ri];
        const float cs8[8] = {p.sw[bj][0].x, p.sw[bj][0].y, p.sw[bj][0].z, p.sw[bj][0].w, p.sw[bj][1].x, p.sw[bj][1].y, p.sw[bj][1].z, p.sw[bj][1].w};
#pragma unroll
        for (int e = 0; e < 8; ++e) v[e] = v0[e] * s * cs8[e];
        if (col < 2048) { const float sc = (col >= 1024) ? 0.08838834764831845f : 1.0f;
#pragma unroll
            for (int q = 0; q < 4; ++q) { const f32x2 cs = p.rot[m][q]; const float x1 = v[2 * q], x2 = v[2 * q + 1];
                w[2 * q] = (x1 * cs.x - x2 * cs.y) * sc; w[2 * q + 1] = (x2 * cs.x + x1 * cs.y) * sc; }
        } else {
#pragma unroll
            for (int e = 0; e < 8; ++e) w[e] = v[e];
        }
        const int bb = row >> 12, t = row & 4095; size_t d;
        if (col < 2048) { const int c = col & 1023; d = (col < 1024 ? P1_Q : P1_K) + ((size_t)(bb * 8 + (c >> 7)) * 4096 + t) * 128 + (c & 127); }
        else if (col < 4096) { const int c = col - 2048; d = P1_V + ((size_t)(bb * 8 + (c >> 8)) * 4096 + t) * 256 + (c & 255); }
        else d = P1_G + (size_t)row * 2048 + (col - 4096);
        *(u32x4*)(O + d) = pack8(w); } };
struct PreLora { f32x4 b[2][2]; };
struct FLora { bf16_t* LW; bf16_t* AA; bf16_t* GT; const float* w0; const float* a0; typedef PreLora Pre;
    DI void prepare(Pre& p, int, int col0) const {
#pragma unroll
        for (int bj = 0; bj < 2; ++bj) { const int col = col0 + bj * 128; const float* src = col < 512 ? w0 + col : (col < 1024 ? a0 + (col - 512) : nullptr);
            if (src) { p.b[bj][0] = *(const f32x4*)src; p.b[bj][1] = *(const f32x4*)(src + 4); } else { p.b[bj][0] = (f32x4){0.f, 0.f, 0.f, 0.f}; p.b[bj][1] = (f32x4){0.f, 0.f, 0.f, 0.f}; } } }
    DI void batch(Pre&, int, int) const {}
    DI void operator()(int row, int col, const float* v, int, int, int bj, const Pre& p) const { float w[8]; bf16_t* dst;
        const float b8[8] = {p.b[bj][0].x, p.b[bj][0].y, p.b[bj][0].z, p.b[bj][0].w, p.b[bj][1].x, p.b[bj][1].y, p.b[bj][1].z, p.b[bj][1].w};
        if (col < 512) { dst = LW + (size_t)row * 512 + col;
#pragma unroll
            for (int e = 0; e < 8; ++e) { const float x = v[e] + b8[e]; const float wl = -softplusf_(-x) - 0.5f; w[e] = -__expf(wl); }
        } else if (col < 1024) { dst = AA + (size_t)row * 512 + (col - 512);
#pragma unroll
            for (int e = 0; e < 8; ++e) w[e] = sigmoidf_(v[e] + b8[e]);
        } else { dst = GT + (size_t)row * 512 + (col - 1024);
#pragma unroll
            for (int e = 0; e < 8; ++e) w[e] = v[e];
        }
        *(u32x4*)dst = pack8(w); } };

constexpr size_t MiB = 1u << 20;
constexpr size_t WS_CTL = 0, CTL_ZERO_BYTES = 192 * 1024;
constexpr size_t WS_CMAX = 64 * 1024;
constexpr size_t WS_SW = 256 * 1024;
constexpr size_t WS_RS = 512 * 1024;
constexpr size_t WS_HB = 448 * MiB;
constexpr size_t WS_ROT = 1 * MiB;
constexpr size_t WS_W = 3 * MiB;
constexpr size_t W_IN0 = WS_W, W_OUT0 = W_IN0 + 8 * MiB, W_UP0 = W_OUT0 + 2 * MiB, W_DN0 = W_UP0 + 8 * MiB, W_IN1 = W_DN0 + 8 * MiB, W_OUT1 = W_IN1 + 12 * MiB,
                 W_UP1 = W_OUT1 + 4 * MiB, W_DN1 = W_UP1 + 8 * MiB, W_LORA = W_DN1 + 8 * MiB;
constexpr size_t R_U = 64 * MiB, R_A = 128 * MiB, R_B = 384 * MiB, WS_END = 512 * MiB;
constexpr size_t WS_LW = R_B, WS_AA = R_B + 32 * MiB, WS_GT = R_B + 64 * MiB, WS_AP = R_B + 96 * MiB;
static_assert(W_LORA + 1536 * 256 * 2 <= R_U, "weights fit below R_U");

constexpr int RING_BYTES = 131072, MISC_OFF = RING_BYTES + 320, LDS_BYTES = 147456;

#define XB_TMO      128
#define XB_XCNT(j)  (256  + 64 * (j))
#define XB_XSUB(j)  (1280 + 64 * (j))
#define XB_XGEN(j)  (2304 + 64 * (j))
#define XB_TOP      3328
#define XB_TOPGEN   3392
#define XCD_BAR_WORDS 3456
#define XB_SPIN_CAP (1u << 22)
DI unsigned xb_ld(unsigned* p)              { return __hip_atomic_load(p, __ATOMIC_RELAXED, __HIP_MEMORY_SCOPE_AGENT); }
DI unsigned xb_add(unsigned* p, unsigned v) { return __hip_atomic_fetch_add(p, v, __ATOMIC_RELAXED, __HIP_MEMORY_SCOPE_AGENT); }
DI unsigned xb_poll(unsigned* p)            { unsigned r; const unsigned z = 0u; asm volatile("global_atomic_add %0, %1, %2, off sc0\n\ts_waitcnt vmcnt(0)" : "=v"(r) : "v"(p), "v"(z) : "memory"); return r; }
DI unsigned xb_xcc_id() { return (unsigned)__builtin_amdgcn_s_getreg((3 << 11) | 20) & 0xFu; }
#define XB_SPIN(cond, bar) do { unsigned _sp = 0; while (cond) { __builtin_amdgcn_s_sleep(1); \
    if ((++_sp & 255u) == 0u) { if (xb_ld(&(bar)[XB_TMO])) break; if (_sp > XB_SPIN_CAP) { atomicAdd(&(bar)[XB_TMO], 1u); break; } } } } while (0)
struct XcdBarrier { unsigned* bar; unsigned x; volatile LAS unsigned* st; };
DI XcdBarrier xcd_barrier_post(unsigned* bar, volatile LAS unsigned* st) {
    XcdBarrier b; b.bar = bar; b.x = xb_xcc_id(); b.st = st;
    if (threadIdx.x == 0) (void)xb_add(&bar[XB_XCNT(b.x)], 1u);
    return b;
}
DI void xcd_barrier_complete(unsigned* bar, unsigned x, unsigned& nloc, unsigned& nx) {
    const unsigned G = gridDim.x * gridDim.y * gridDim.z;
    unsigned sum, cnt, mine, sp = 0u;
    for (;;) {
        sum = 0u; cnt = 0u; mine = 0u;
#pragma unroll
        for (unsigned j = 0; j < 16; ++j) { const unsigned c = xb_ld(&bar[XB_XCNT(j)]); sum += c; cnt += (c > 0u) ? 1u : 0u; mine = (j == x) ? c : mine; }
        if (sum == G) break;
        __builtin_amdgcn_s_sleep(1);
        if ((++sp & 255u) == 0u) { if (xb_ld(&bar[XB_TMO])) break; if (sp > XB_SPIN_CAP) { atomicAdd(&bar[XB_TMO], 1u); break; } }
    }
    nloc = mine > 0u ? mine : 1u; nx = cnt > 0u ? cnt : 1u;
}
DI void xcd_barrier(const XcdBarrier& b) {
    asm volatile("s_waitcnt vmcnt(0)" ::: "memory");
    __syncthreads();
    if (threadIdx.x == 0) {
        unsigned* bar = b.bar;
        __builtin_amdgcn_s_waitcnt(0);
        unsigned nloc = b.st[0], nx = b.st[1];
        if (nloc == 0u) { xcd_barrier_complete(bar, b.x, nloc, nx); b.st[0] = nloc; b.st[1] = nx; }
        const unsigned old = xb_add(&bar[XB_XSUB(b.x)], 1u);
        const unsigned gen = old / nloc;
        if (old + 1u == (gen + 1u) * nloc) {
            __builtin_amdgcn_fence(__ATOMIC_RELEASE, "agent");
            asm volatile("s_waitcnt vmcnt(0)" ::: "memory");
            const unsigned og = xb_add(&bar[XB_TOP], 1u);
            const unsigned tg = og / nx;
            if (og + 1u == (tg + 1u) * nx) xb_add(&bar[XB_TOPGEN], 1u);
            else XB_SPIN(xb_poll(&bar[XB_TOPGEN]) == tg, bar);
            __builtin_amdgcn_fence(__ATOMIC_ACQUIRE, "agent");
            xb_add(&bar[XB_XGEN(b.x)], 1u);
            asm volatile("s_waitcnt vmcnt(0)" ::: "memory");
        } else {
            XB_SPIN(xb_poll(&bar[XB_XGEN(b.x)]) == gen, bar);
            __builtin_amdgcn_fence(__ATOMIC_ACQUIRE, "agent");
            asm volatile("s_waitcnt vmcnt(0)" ::: "memory");
        }
    }
    __syncthreads();
}

template <int CTRL> DI float dppmov(float x) { return __int_as_float(__builtin_amdgcn_update_dpp(0, __float_as_int(x), CTRL, 0xF, 0xF, true)); }
DI float red8(float x) { x += dppmov<0xB1>(x); x += dppmov<0x4E>(x); x += dppmov<0x141>(x); return x; }
DI float red16(float x) { x = red8(x); x += dppmov<0x140>(x); return x; }
DI float red16max(float x) { x = fmaxf(x, dppmov<0xB1>(x)); x = fmaxf(x, dppmov<0x4E>(x)); x = fmaxf(x, dppmov<0x141>(x)); x = fmaxf(x, dppmov<0x140>(x)); return x; }
DI float rlane(float x, int l) { return __int_as_float(__builtin_amdgcn_readlane(__float_as_int(x), l)); }
DI float wave_sum(float v) { v = red16(v); return (rlane(v, 0) + rlane(v, 16)) + (rlane(v, 32) + rlane(v, 48)); }
DI float wave_max(float v) { v = red16max(v); return fmaxf(fmaxf(rlane(v, 0), rlane(v, 16)), fmaxf(rlane(v, 32), rlane(v, 48))); }

DI int lane_id() { int l; asm volatile("v_mbcnt_lo_u32_b32 %0, -1, 0\n\tv_mbcnt_hi_u32_b32 %0, -1, %0" : "=v"(l)); return l; }
struct Ctx { LAS unsigned char* lds; int wave, vcu, G; };

struct TrRegs { f32x4 v[8]; float sc[8]; f32x4 cs; };
DI void tr_issue(TrRegs& L, const float* W, const float* ksc, const unsigned* cmax, int Nsrc, int Npad, int item, int lane) {
    const int nblk = Npad / 32, kb = item / nblk, nb = item % nblk, k0 = 64 * kb, n = 32 * nb + 4 * (lane & 7), rr = lane >> 3; const bool ok = n < Nsrc;
#pragma unroll
    for (int i = 0; i < 8; ++i) { const int k = k0 + 8 * i + rr; L.v[i] = (f32x4){0.f, 0.f, 0.f, 0.f}; if (ok) L.v[i] = *(const f32x4*)(W + (size_t)k * Nsrc + n); L.sc[i] = ksc ? ksc[k] : 1.0f; }
    if (cmax) { const u32x4 m = *(const u32x4*)(cmax + n);
        L.cs = (f32x4){127.0f / fmaxf(__uint_as_float(m.x), 1e-30f), 127.0f / fmaxf(__uint_as_float(m.y), 1e-30f), 127.0f / fmaxf(__uint_as_float(m.z), 1e-30f), 127.0f / fmaxf(__uint_as_float(m.w), 1e-30f)}; }
}
DI void tr_to_lds(const TrRegs& L, bool q, LAS float* scr, int lane) {
    const int rr = lane >> 3, c4 = 4 * (lane & 7);
#pragma unroll
    for (int i = 0; i < 8; ++i) { f32x4 x = L.v[i] * L.sc[i]; if (q) x = x * L.cs; LAS float* d = scr + (8 * i + rr) * 33 + c4; d[0] = x.x; d[1] = x.y; d[2] = x.z; d[3] = x.w; }
    asm volatile("s_waitcnt lgkmcnt(0)" ::: "memory");
}
DI void tr_store(int K, int Npad, bf16_t* WT, const LAS float* scr, int item, int lane) {
    const int nblk = Npad / 32, kb = item / nblk, nb = item % nblk, k0 = 64 * kb, n0 = 32 * nb, c = lane >> 3;
#pragma unroll
    for (int j = 0; j < 4; ++j) { const int nn = (lane & 7) + 8 * j; const LAS float* p = scr + (8 * c) * 33 + nn;
        u32x4 o; o.x = cvtpk(p[0 * 33], p[1 * 33]); o.y = cvtpk(p[2 * 33], p[3 * 33]); o.z = cvtpk(p[4 * 33], p[5 * 33]); o.w = cvtpk(p[6 * 33], p[7 * 33]);
        *(u32x4*)(WT + (size_t)(n0 + nn) * K + k0 + 8 * c) = o; }
    asm volatile("s_waitcnt lgkmcnt(0)" ::: "memory");
}
DI void tr_store_q(int K, int Npad, signed char* WT, const LAS float* scr, int item, int lane) {
    const int nblk = Npad / 32, kb = item / nblk, nb = item % nblk, k0 = 64 * kb, n0 = 32 * nb, c = lane >> 4;
#pragma unroll
    for (int j = 0; j < 2; ++j) { const int nn = (lane & 15) + 16 * j; const LAS float* sp = scr + (16 * c) * 33 + nn; unsigned o[4];
#pragma unroll
        for (int q = 0; q < 4; ++q) { unsigned wv = 0;
#pragma unroll
            for (int e = 0; e < 4; ++e) { const int iv = (int)rintf(sp[(4 * q + e) * 33]); wv |= ((unsigned)iv & 0xffu) << (8 * e); }
            o[q] = wv; }
        *(u32x4*)(WT + (size_t)(n0 + nn) * K + k0 + 16 * c) = (u32x4){o[0], o[1], o[2], o[3]}; }
    asm volatile("s_waitcnt lgkmcnt(0)" ::: "memory");
}
DI void rows2_to_bf16_rs(const float* x, bf16_t* o, float* rsout, int m0, int m1, int lane) {
    const int mm[2] = {m0, m1}; f32x4 v[2][4];
#pragma unroll
    for (int r = 0; r < 2; ++r) { const f32x4* xr = (const f32x4*)(x + (size_t)mm[r] * DM) + lane;
#pragma unroll
        for (int j = 0; j < 4; ++j) v[r][j] = __builtin_nontemporal_load(xr + 64 * j); }
#pragma unroll
    for (int r = 0; r < 2; ++r) { float s = 0.f;
#pragma unroll
        for (int j = 0; j < 4; ++j) s += (v[r][j].x * v[r][j].x + v[r][j].y * v[r][j].y) + (v[r][j].z * v[r][j].z + v[r][j].w * v[r][j].w);
        const float rs = __builtin_amdgcn_rsqf(wave_sum(s) * (1.f / DM) + RMS_EPS);
        u32x2* o8 = (u32x2*)(o + (size_t)mm[r] * DM) + lane;
#pragma unroll
        for (int j = 0; j < 4; ++j) { u32x2 w; w.x = cvtpk(v[r][j].x, v[r][j].y); w.y = cvtpk(v[r][j].z, v[r][j].w); o8[64 * j] = w; }
        if (lane == 0) rsout[mm[r]] = rs; }
}
struct WDesc { const float* W; int K, Nsrc, Npad; bf16_t* WT; };
DI void colmax_item(const float* W, const float* ksc, unsigned* cmax, int N, int it, int lane) {
    const int ncb = N >> 8, cb = it % ncb, kb = it / ncb, n = cb * 256 + lane * 4; f32x4 mx = {0.f, 0.f, 0.f, 0.f};
#pragma unroll
    for (int h = 0; h < 2; ++h) { f32x4 v[16];
#pragma unroll
        for (int kk = 0; kk < 16; ++kk) v[kk] = *(const f32x4*)(W + (size_t)(kb * 32 + h * 16 + kk) * N + n);
#pragma unroll
        for (int kk = 0; kk < 16; ++kk) { const float sc = ksc[kb * 32 + h * 16 + kk];
            mx.x = fmaxf(mx.x, fabsf(v[kk].x * sc)); mx.y = fmaxf(mx.y, fabsf(v[kk].y * sc)); mx.z = fmaxf(mx.z, fabsf(v[kk].z * sc)); mx.w = fmaxf(mx.w, fabsf(v[kk].w * sc)); } }
    atomicMax(cmax + n, __float_as_uint(mx.x)); atomicMax(cmax + n + 1, __float_as_uint(mx.y)); atomicMax(cmax + n + 2, __float_as_uint(mx.z)); atomicMax(cmax + n + 3, __float_as_uint(mx.w));
}
#ifndef Q8_MASK_V
#define Q8_MASK_V 0x54
#endif
constexpr int Q8_MASK = Q8_MASK_V;
DI int q8slot(int wsel) { return wsel == 0 ? 0 : (wsel == 2 ? 1 : (wsel == 4 ? 2 : 3)); }
#ifndef WT_RW
#define WT_RW 1
#define WT_GD 1
#endif
DI void p_weights(const Ctx& C, const float* const* in, unsigned char* ws, int wlo, int whi, bool with_rot, int gw, int NGW) {
    LAS float* scr = (LAS float*)(C.lds + C.wave * 16384);
    {
        const float* Wsrc[8] = {in[7], in[23], in[5], in[6], in[24], in[26], in[5] + (size_t)DM * FF, in[6] + (size_t)FF * DM};
        const int Kk[8] = {1024, 1024, 1024, 4096, 1024, 2048, 1024, 4096};
        const int Ns[8] = {AB_IN, 1024, 4096, 1024, RET_IN, 1024, 4096, 1024};
        const int Np[8] = {AB_PAD, 1024, 4096, 1024, RET_IN, 1024, 4096, 1024};
        const size_t off[8] = {W_IN0, W_OUT0, W_UP0, W_DN0, W_IN1, W_OUT1, W_UP1, W_DN1};
        const float* Ksc[8] = {in[1], nullptr, in[3], nullptr, in[1] + DM, nullptr, in[3] + DM, nullptr};
        int base = 0;
#pragma unroll
        for (int wsel = 0; wsel < 8; ++wsel) {
            if (wsel < wlo || wsel >= whi) continue;
            const int items = (Kk[wsel] / 64) * (Np[wsel] / 32);
            int first = gw - (base % NGW); if (first < 0) first += NGW;
            const bool q8 = (Q8_MASK >> wsel) & 1;
            const unsigned* cm = q8 ? (const unsigned*)(ws + WS_CMAX) + q8slot(wsel) * 6144 : nullptr;
            TrRegs L; const int lane = lane_id();
            if (first < items) tr_issue(L, Wsrc[wsel], Ksc[wsel], cm, Ns[wsel], Np[wsel], first, lane);
            for (int it = first; it < items; it += NGW) {
                tr_to_lds(L, q8, scr, lane);
                if (it + NGW < items) tr_issue(L, Wsrc[wsel], Ksc[wsel], cm, Ns[wsel], Np[wsel], it + NGW, lane);
                if (q8) tr_store_q(Kk[wsel], Np[wsel], (signed char*)(ws + off[wsel]), scr, it, lane); else tr_store(Kk[wsel], Np[wsel], (bf16_t*)(ws + off[wsel]), scr, it, lane);
            }
            if (q8) { float* swp = (float*)(ws + WS_SW) + q8slot(wsel) * 6144; for (int n = gw * 64 + lane; n < Ns[wsel]; n += NGW * 64) swp[n] = __uint_as_float(cm[n]) * (1.0f / 127.0f); }
            base += items;
        }
    }
    if (with_rot) {
        f32x2* rot = (f32x2*)(ws + WS_ROT); const int gt = gw * 64 + lane_id(), NT = NGW * 64;
        for (int i = gt; i < SEQ * 64; i += NT) { const int pos = i >> 6, j = i & 63;
            const float ang = 1.0f / powf(10000.0f, (float)j * (1.0f / 63.0f)); const float th = (float)pos * ang; float sn, cs; sincosf(th, &sn, &cs); rot[i] = (f32x2){cs, sn}; }
    }
}
DI void p_prologue(const Ctx& C, const float* const* in, unsigned char* ws) {
    const int gw = C.vcu * 8 + C.wave, NGW = C.G * 8;
    p_weights(C, in, ws, 0, 1, false, gw, NGW);
    {
        static_assert(Q8_MASK == 0x54, "colmax item list assumes in1, up0, up1");
        constexpr int I1 = (RET_IN / 256) * 32, I2 = (FF / 256) * 32; unsigned* cm = (unsigned*)(ws + WS_CMAX); const int lane = lane_id();
        for (int it = gw; it < I1 + 2 * I2; it += NGW) {
            if (it < I1) colmax_item(in[24], in[1] + DM, cm + 2 * 6144, RET_IN, it, lane);
            else if (it < I1 + I2) colmax_item(in[5], in[3], cm + 1 * 6144, FF, it - I1, lane);
            else colmax_item(in[5] + (size_t)DM * FF, in[3] + DM, cm + 3 * 6144, FF, it - I1 - I2, lane);
        }
    }
    {
        bf16_t* BL = (bf16_t*)(ws + W_LORA); const float* w2 = in[14]; const float* a2 = in[16]; const float* g2 = in[17];
        const int gt = (C.vcu * 8 + C.wave) * 64 + lane_id(), NT = C.G * 512;
        for (int i = gt; i < 1536 * 256; i += NT) { const int n = i >> 8, k = i & 255; float v = 0.f;
            if (n < 512) { if (k < 64) v = w2[k * 512 + n]; }
            else if (n < 1024) { if (k >= 64 && k < 128) v = a2[(k - 64) * 512 + (n - 512)]; }
            else { if (k >= 128) v = g2[(k - 128) * 512 + (n - 1024)]; }
            BL[i] = (bf16_t)(cvtpk(v, 0.f) & 0xffffu); }
    }
    bf16_t* U = (bf16_t*)(ws + R_U); float* RS = (float*)(ws + WS_RS);
    for (int m = gw; m < MTOK; m += 2 * NGW) rows2_to_bf16_rs(in[0], U, RS, m, (m + NGW < MTOK) ? m + NGW : m, lane_id());
}

DI void p_norm(const Ctx& C, const float* xbase, const bf16_t* hin, const bf16_t* mix, const float* wpost, bf16_t* hout, float* out32, float* RS, signed char* hq = nullptr) {
    const int gw = C.vcu * 8 + C.wave, NGW = C.G * 8, lane = lane_id();
    for (int m0 = gw; m0 < MTOK; m0 += 2 * NGW) {
        const int mm[2] = {m0, (m0 + NGW < MTOK) ? m0 + NGW : m0};
        u32x2 mw[2][4], hw[2][4]; f32x4 bv[2][4];
#pragma unroll
        for (int r = 0; r < 2; ++r) { const int m = mm[r]; const u32x2* mr = (const u32x2*)(mix + (size_t)m * DM) + lane;
#pragma unroll
            for (int j = 0; j < 4; ++j) { mw[r][j] = __builtin_nontemporal_load(mr + 64 * j);
                if (xbase) bv[r][j] = __builtin_nontemporal_load((const f32x4*)(xbase + (size_t)m * DM) + lane + 64 * j);
                else hw[r][j] = ((const u32x2*)(hin + (size_t)m * DM) + lane)[64 * j]; } }
#pragma unroll
        for (int r = 0; r < 2; ++r) { const int m = mm[r]; f32x4 mv[4]; float s = 0.f;
#pragma unroll
            for (int j = 0; j < 4; ++j) { const u32x2 w = mw[r][j]; mv[j] = (f32x4){bflo(w.x), bfhi(w.x), bflo(w.y), bfhi(w.y)};
                if (!xbase) { const u32x2 h = hw[r][j]; bv[r][j] = (f32x4){bflo(h.x), bfhi(h.x), bflo(h.y), bfhi(h.y)}; }
                s += (mv[j].x * mv[j].x + mv[j].y * mv[j].y) + (mv[j].z * mv[j].z + mv[j].w * mv[j].w); }
            const float rs = __builtin_amdgcn_rsqf(wave_sum(s) * (1.f / DM) + RMS_EPS);
            float s2 = 0.f; f32x4* b = bv[r];
#pragma unroll
            for (int j = 0; j < 4; ++j) { const f32x4 wp = ((const f32x4*)wpost)[64 * j + lane]; b[j] = b[j] + mv[j] * rs * wp;
                s2 += (b[j].x * b[j].x + b[j].y * b[j].y) + (b[j].z * b[j].z + b[j].w * b[j].w); }
            if (out32) { f32x4* ho = (f32x4*)(out32 + (size_t)m * DM) + lane;
#pragma unroll
                for (int j = 0; j < 4; ++j) ho[64 * j] = b[j]; }
            if (hout) {
                const float rs2 = __builtin_amdgcn_rsqf(wave_sum(s2) * (1.f / DM) + RMS_EPS);
                u32x2* uo = (u32x2*)(hout + (size_t)m * DM) + lane;
#pragma unroll
                for (int j = 0; j < 4; ++j) { u32x2 o; o.x = cvtpk(b[j].x, b[j].y); o.y = cvtpk(b[j].z, b[j].w); uo[64 * j] = o; }
                float cs = rs2;
                if (hq) {
                    float amax = 0.f;
#pragma unroll
                    for (int j = 0; j < 4; ++j) amax = fmaxf(amax, fmaxf(fmaxf(fabsf(b[j].x), fabsf(b[j].y)), fmaxf(fabsf(b[j].z), fabsf(b[j].w))));
                    amax = fmaxf(wave_max(amax), 1e-20f); const float inv = 127.0f * __builtin_amdgcn_rcpf(amax); cs = rs2 * amax * (1.0f / 127.0f);
                    unsigned* qo = (unsigned*)(hq + (size_t)m * DM) + lane;
#pragma unroll
                    for (int j = 0; j < 4; ++j) { const int q0 = (int)rintf(b[j].x * inv), q1 = (int)rintf(b[j].y * inv), q2 = (int)rintf(b[j].z * inv), q3 = (int)rintf(b[j].w * inv);
                        qo[64 * j] = ((unsigned)q0 & 0xffu) | (((unsigned)q1 & 0xffu) << 8) | (((unsigned)q2 & 0xffu) << 16) | (((unsigned)q3 & 0xffu) << 24); }
                }
                if (lane == 0) RS[m] = cs;
            }
        }
    }
}

DI void p_lora_pre(const Ctx& C, const bf16_t* p0, const float* mu, bf16_t* AP) {
    const int gt = (C.vcu * 8 + C.wave) * 64 + lane_id(), NT = C.G * 512;
    const int j0 = (gt & 31) * 8; float mv[8];
#pragma unroll
    for (int e = 0; e < 8; ++e) mv[e] = mu[1536 + j0 + e];
    constexpr int NB = 4;
    for (int i0 = gt; i0 < MTOK * 32; i0 += NB * NT) {
        u32x4 cur[NB], prv[NB];
#pragma unroll
        for (int q = 0; q < NB; ++q) { const int m = (i0 + q * NT) >> 5; cur[q] = *(const u32x4*)(p0 + (size_t)m * AB_PAD + 3600 + j0); prv[q] = (u32x4){0u, 0u, 0u, 0u};
            if ((m & (SEQ - 1)) != 0) prv[q] = *(const u32x4*)(p0 + (size_t)(m - 1) * AB_PAD + 3600 + j0); }
#pragma unroll
        for (int q = 0; q < NB; ++q) { const int m = (i0 + q * NT) >> 5; float c[8], p[8], o[8]; unpack8(cur[q], c); unpack8(prv[q], p);
#pragma unroll
            for (int e = 0; e < 8; ++e) { const float xs = c[e] + (p[e] - c[e]) * mv[e];
                o[e] = (j0 < 64) ? (1.0f - 2.0f * __builtin_amdgcn_rcpf(1.0f + __expf(2.0f * xs))) : (j0 < 128 ? xs : sigmoidf_(xs)); }
            *(u32x4*)(AP + (size_t)m * 256 + j0) = pack8(o); }
    }
}

struct ScanArgs { const bf16_t* p0; bf16_t* oab; bf16_t* EB; const float* conv_w; const float* a_log; const float* dt_bias; const float* gnw;
    const float* mu; const float* k_k; const float* k_a; const float* r_k; const float* ln_w; const float* ln_b; const bf16_t* LW; const bf16_t* AA; const bf16_t* GT; };
DI void p_mix_post(const Ctx& C, const ScanArgs& A) {
    const int gt = (C.vcu * 8 + C.wave) * 64 + lane_id(), NT = C.G * 512;
    for (int i = gt; i < MTOK * 128; i += NT) {
        const int m = i >> 7, ch = (i & 127) * 8, hs = ch >> 6; bf16_t* p = A.oab + (size_t)m * DM + ch;
        float y[8]; unpack8(*(const u32x4*)p, y);
        if (hs < 8) {
            float ss = 0.f;
#pragma unroll
            for (int e = 0; e < 8; ++e) ss += y[e] * y[e];
            ss = red8(ss); const float r = __builtin_amdgcn_rsqf(ss * (1.f / 64.f) + RMS_EPS);
            float z[8]; unpack8(*(const u32x4*)(A.p0 + (size_t)m * AB_PAD + 1536 + ch), z);
#pragma unroll
            for (int e = 0; e < 8; ++e) y[e] = y[e] * r * A.gnw[(ch & 63) + e] * siluf_(z[e]);
        } else {
            const int cc = ch - 512; float s1 = 0.f;
#pragma unroll
            for (int e = 0; e < 8; ++e) s1 += y[e];
            const float mean = red8(s1) * (1.f / 64.f); float s2 = 0.f;
#pragma unroll
            for (int e = 0; e < 8; ++e) { y[e] -= mean; s2 += y[e] * y[e]; }
            const float rstd = __builtin_amdgcn_rsqf(red8(s2) * (1.f / 64.f) + 64e-5f);
            float gtv[8], eb[8]; unpack8(*(const u32x4*)(A.GT + (size_t)m * 512 + cc), gtv); unpack8(*(const u32x4*)(A.EB + (size_t)m * 512 + cc), eb);
#pragma unroll
            for (int e = 0; e < 8; ++e) y[e] = y[e] * rstd * A.ln_w[cc + e] * gtv[e] + eb[e];
        }
        *(u32x4*)p = pack8(y);
    }
}

constexpr int RC = 64;
constexpr int RSEG = 4, RSEGLEN = SEQ / RSEG;
constexpr int QP = 136, KDP = 160, VP = 288, PP = 72;
constexpr int L_GT = 0;
constexpr int L_Q = 512, L_K = L_Q + RC * QP * 2, L_KD = L_K + RC * QP * 2, L_V = L_KD + RC * KDP * 2, L_P = L_V + RC * VP * 2, L_END = L_P + RC * PP * 2;
constexpr int OSP = 260;
static_assert(L_END <= RING_BYTES && 512 + RC * OSP * 4 <= L_P, "retention LDS");
DI int crow(int reg, int hh) { return (reg & 3) + 8 * (reg >> 2) + 4 * hh; }
DI bf16x8 frag_contig(const LAS bf16_t* p) { return *(const LAS bf16x8*)p; }
typedef short v4i16_t __attribute__((ext_vector_type(4)));
DI bf16x8 frag_tr(const LAS bf16_t* tile, int pitch, int krow0, int n0, int lane) {
    const int hh = lane >> 5, blk = (lane >> 4) & 1, q = (lane & 15) >> 2, p = lane & 3;
    const LAS bf16_t* a = tile + (krow0 + 8 * hh + q) * pitch + n0 + 16 * blk + 4 * p;
    const s16x4 lo = __builtin_bit_cast(s16x4, __builtin_amdgcn_ds_read_tr16_b64_v4i16((LAS v4i16_t*)a));
    const s16x4 hi = __builtin_bit_cast(s16x4, __builtin_amdgcn_ds_read_tr16_b64_v4i16((LAS v4i16_t*)(a + 4 * pitch)));
    return __builtin_shufflevector(lo, hi, 0, 1, 2, 3, 4, 5, 6, 7);
}
DI bf16x8 frag_tr_perm(const LAS bf16_t* tile, int pitch, int s, int n0, int lane) {
    const int hh = lane >> 5, blk = (lane >> 4) & 1, q = (lane & 15) >> 2, p = lane & 3;
    const LAS bf16_t* a = tile + (16 * s + 4 * hh + q) * pitch + n0 + 16 * blk + 4 * p;
    const s16x4 lo = __builtin_bit_cast(s16x4, __builtin_amdgcn_ds_read_tr16_b64_v4i16((LAS v4i16_t*)a));
    const s16x4 hi = __builtin_bit_cast(s16x4, __builtin_amdgcn_ds_read_tr16_b64_v4i16((LAS v4i16_t*)(a + 8 * pitch)));
    return __builtin_shufflevector(lo, hi, 0, 1, 2, 3, 4, 5, 6, 7);
}
DI bf16x8 frag_perm(const LAS bf16_t* p) { const s16x4 lo = *(const LAS s16x4*)p, hi = *(const LAS s16x4*)(p + 8); return __builtin_shufflevector(lo, hi, 0, 1, 2, 3, 4, 5, 6, 7); }
DI bf16x8 pack_step(const f32x16& x, int s) { u32x4 p; p.x = cvtpk(x[8 * s], x[8 * s + 1]); p.y = cvtpk(x[8 * s + 2], x[8 * s + 3]); p.z = cvtpk(x[8 * s + 4], x[8 * s + 5]); p.w = cvtpk(x[8 * s + 6], x[8 * s + 7]); return __builtin_bit_cast(bf16x8, p); }
#define MFMA32(a, b, c) __builtin_amdgcn_mfma_f32_32x32x16_bf16((a), (b), (c), 0, 0, 0)

namespace ck {
constexpr int CL = 32, NCH = SEQ / CL;
constexpr int AP = 72, TP = 40, NP = 36;
constexpr int O_AT = 0, O_RT = O_AT + 4608, O_BN = O_RT + 4608, O_KN = O_BN + 4608, O_V = O_KN + 4608, O_CL = O_V + 2048, TBSZ = O_CL + 256;
constexpr int O_TM = 0, O_NLO = O_TM + 2560, O_NAK = O_NLO + 2560, O_NBR = O_NAK + 2560, O_NKR = O_NBR + 2560, TNSZ = O_NKR + 2560;
constexpr int O_TB = 0, O_TN = O_TB + 4 * TBSZ, O_NAB = O_TN + 2 * TNSZ, O_TOT = O_NAB + 32 * NP * 4, O_CW = O_TOT + 2048, O_ST = O_CW + 2560, O_FLAG = O_ST + 8192, O_END = O_FLAG + 16;
static_assert(O_END <= RING_BYTES, "chunk-scan LDS");
}
#define CK_BAR() do { asm volatile("s_waitcnt lgkmcnt(0)" ::: "memory"); __builtin_amdgcn_s_barrier(); asm volatile("" ::: "memory"); } while (0)

template <bool RWKV>
DI void chunk_task(const Ctx& C, const ScanArgs& A, int b, int h, int half) {
    using namespace ck;
    int lane = lane_id(), tid = C.wave * 64 + lane, r = lane & 31, hh = lane >> 5; const int w = C.wave;
    LAS float* Nab = (LAS float*)(C.lds + O_NAB); LAS float* tot = (LAS float*)(C.lds + O_TOT); LAS float* cw = (LAS float*)(C.lds + O_CW);
    int pt = (tid >> 3) & 31, ps = tid & 7;
    bool own = (ps >> 2) == half;
    __syncthreads();
    float nalog = 0.f, dtb = 0.f;
    if (RWKV) { if (tid < 448) { const int a_ = tid >> 6, ch = tid & 63; const float* src = a_ == 0 ? A.mu : (a_ == 1 ? A.mu + 512 : (a_ == 2 ? A.mu + 1024 : (a_ == 3 ? A.k_k : (a_ == 4 ? A.k_a : (a_ == 5 ? A.r_k : A.ln_b))))); cw[tid] = src[h * 64 + ch]; } }
    if (!RWKV) { nalog = -__expf(A.a_log[h]); dtb = A.dt_bias[h];
        for (int i = tid; i < 640; i += 512) { const int j = i / 160, ch = i % 160; const int col = ch < 64 ? h * 64 + ch : (ch < 128 ? 512 + h * 64 + (ch - 64) : 1024 + h * 64 + 32 * half + (ch - 128)); cw[i] = A.conv_w[j * 1536 + col]; } }
    __syncthreads();
    u32x4 L0[4], L1[4], L2[4];
    unsigned short araw = 0, braw = 0;
    auto ldq = [](const bf16_t* base, unsigned boff) { return *(const u32x4*)((const char*)base + boff); };
    auto issue = [&](int c) {
        const int t0 = c * CL; const u32x4 Z4 = {0u, 0u, 0u, 0u};
        if (RWKV) {
            const size_t mu_ = (size_t)b * SEQ + t0; const bf16_t* rb = A.p0 + mu_ * AB_PAD + RP0 + h * 64; const bf16_t* rp = rb - AB_PAD;
            const unsigned o = ((unsigned)pt * AB_PAD + 8u * ps) * 2u, o5 = ((unsigned)pt * 512u + 8u * ps) * 2u; const bool hp = (t0 + pt) != 0;
            L0[0] = ldq(rb, o); L0[2] = ldq(rb, o + 1024u); L0[1] = Z4; L0[3] = Z4; L1[0] = Z4; L1[1] = Z4; L2[0] = Z4;
            if (hp) { L0[1] = ldq(rp, o); L0[3] = ldq(rp, o + 1024u); }
            if (own) { L1[0] = ldq(rb, o + 2048u); if (hp) L1[1] = ldq(rp, o + 2048u); L2[0] = ldq(A.GT + mu_ * 512 + h * 64, o5); }
            L1[2] = ldq(A.LW + mu_ * 512 + h * 64, o5); L1[3] = ldq(A.AA + mu_ * 512 + h * 64, o5);
        } else {
            const bf16_t* rb = A.p0 + ((size_t)b * SEQ + t0) * AB_PAD + h * 64;
#pragma unroll
            for (int tp = 0; tp < 4; ++tp) { const int ts = t0 + pt - 3 + tp; L0[tp] = Z4; L1[tp] = Z4;
                if (ts >= 0) { const bf16_t* rt_ = rb - (3 - tp) * AB_PAD; const unsigned o = ((unsigned)pt * AB_PAD + 8u * ps) * 2u; L0[tp] = ldq(rt_, o); L1[tp] = ldq(rt_, o + 1024u); } }
            { const unsigned o = ((unsigned)pt * AB_PAD) * 2u; const char* sb = (const char*)(rb - h * 64 + 2048 + h); braw = *(const bf16_t*)(sb + o); araw = *(const bf16_t*)(sb + o + 16u); }
        }
    };
    auto issue_v = [&](int c) {
        const int idx = (w - 5) * 64 + lane, vt = idx >> 2, vg = idx & 3;
        const bf16_t* rb = A.p0 + ((size_t)b * SEQ + c * CL) * AB_PAD + 1024 + h * 64 + 32 * half;
#pragma unroll
        for (int tp = 0; tp < 4; ++tp) { const int ts = c * CL + vt - 3 + tp; L2[tp] = (u32x4){0u, 0u, 0u, 0u};
            if (ts >= 0) L2[tp] = ldq(rb - (3 - tp) * AB_PAD, ((unsigned)vt * AB_PAD + 8u * vg) * 2u); }
    };
    auto conv8 = [&](const u32x4* rr, int wch, float* out) {
        float acc[8] = {0.f, 0.f, 0.f, 0.f, 0.f, 0.f, 0.f, 0.f};
#pragma unroll
        for (int tp = 0; tp < 4; ++tp) { float x[8]; unpack8(rr[tp], x);
            const f32x4 w0 = *(const LAS f32x4*)(cw + tp * 160 + wch), w1 = *(const LAS f32x4*)(cw + tp * 160 + wch + 4);
            acc[0] += w0.x * x[0]; acc[1] += w0.y * x[1]; acc[2] += w0.z * x[2]; acc[3] += w0.w * x[3];
            acc[4] += w1.x * x[4]; acc[5] += w1.y * x[5]; acc[6] += w1.z * x[6]; acc[7] += w1.w * x[7]; }
#pragma unroll
        for (int e = 0; e < 8; ++e) out[e] = siluf_(acc[e]);
    };
    float vlw[8], vci[8]; u32x4 pkk, pb, pk, pr;
    auto stage1 = [&](int c) {
        LAS bf16_t* Vv = (LAS bf16_t*)(C.lds + O_TB + (c & 3) * TBSZ + O_V);
        const size_t m = (size_t)b * SEQ + c * CL + pt; float v8[8], vkk[8], vb[8], vk[8], vr[8];
        if (RWKV) {
            const int pc = h * 64 + 8 * ps; float x[8], y[8], kr[8], a[8]; const LAS float* pw = cw + 8 * ps;
            unpack8(L0[0], x); unpack8(L0[1], y);
#pragma unroll
            for (int e = 0; e < 8; ++e) vr[e] = x[e] + (y[e] - x[e]) * pw[e];
            unpack8(L0[2], x); unpack8(L0[3], y);
#pragma unroll
            for (int e = 0; e < 8; ++e) kr[e] = x[e] + (y[e] - x[e]) * pw[64 + e];
            unpack8(L1[0], x); unpack8(L1[1], y);
#pragma unroll
            for (int e = 0; e < 8; ++e) v8[e] = x[e] + (y[e] - x[e]) * pw[128 + e];
            unpack8(L1[2], vlw); unpack8(L1[3], a);
            float kx[8], skk = 0.f;
#pragma unroll
            for (int e = 0; e < 8; ++e) { kx[e] = kr[e] * pw[192 + e]; skk += kx[e] * kx[e]; }
            skk = red8(skk); const float rn = __builtin_amdgcn_rsqf(skk + 1e-6f); float rkr = 0.f;
#pragma unroll
            for (int e = 0; e < 8; ++e) { vkk[e] = kx[e] * rn; vk[e] = kr[e] * (1.0f + (a[e] - 1.0f) * pw[256 + e]); vb[e] = vkk[e] * a[e]; rkr += vr[e] * vk[e] * pw[320 + e]; }
            rkr = red8(rkr);
            if (own) { float gt[8], eo[8]; unpack8(L2[0], gt);
#pragma unroll
                for (int e = 0; e < 8; ++e) eo[e] = (pw[384 + e] + rkr * v8[e]) * gt[e];
                *(u32x4*)(A.EB + m * 512 + pc) = pack8(eo); }
        } else {
            float q[8], k[8]; conv8(L0, 8 * ps, q); conv8(L1, 64 + 8 * ps, k);
            float sq = 0.f, sk = 0.f;
#pragma unroll
            for (int e = 0; e < 8; ++e) { sq += q[e] * q[e]; sk += k[e] * k[e]; }
            sq = red8(sq); sk = red8(sk);
            const float rq_ = 0.125f * __builtin_amdgcn_rsqf(sq + 1e-6f), rk_ = __builtin_amdgcn_rsqf(sk + 1e-6f);
            const float beta = sigmoidf_(bf1(braw)), gl = nalog * softplusf_(bf1(araw) + dtb), al = __expf(gl);
#pragma unroll
            for (int e = 0; e < 8; ++e) { const float kh = k[e] * rk_; vkk[e] = kh; vb[e] = al * beta * kh; vk[e] = beta * kh; vr[e] = q[e] * rq_; vlw[e] = gl; }
        }
        if (RWKV) { if (own) *(LAS u32x4*)(Vv + pt * 32 + 8 * (ps & 3)) = pack8(v8); }
        pkk = pack8(vkk); pb = pack8(vb); pk = pack8(vk); pr = pack8(vr);
        const int tl = lane >> 3;
        if (!RWKV) { float x = vlw[0];
            float y1 = __shfl_up(x, 8);  if (tl >= 1) x += y1;
            float y2 = __shfl_up(x, 16); if (tl >= 2) x += y2;
            float y4 = __shfl_up(x, 32); if (tl >= 4) x += y4;
#pragma unroll
            for (int e = 0; e < 8; ++e) vci[e] = x; }
        else
#pragma unroll
        for (int e = 0; e < 8; ++e) { float x = vlw[e];
            float y1 = __shfl_up(x, 8);  if (tl >= 1) x += y1;
            float y2 = __shfl_up(x, 16); if (tl >= 2) x += y2;
            float y4 = __shfl_up(x, 32); if (tl >= 4) x += y4;
            vci[e] = x; }
        if (tl == 7) { LAS float* tp_ = tot + (c & 1) * 256 + (pt >> 3) * 64 + 8 * ps; *(LAS f32x4*)tp_ = (f32x4){vci[0], vci[1], vci[2], vci[3]}; *(LAS f32x4*)(tp_ + 4) = (f32x4){vci[4], vci[5], vci[6], vci[7]}; }
    };
    auto stage3 = [&](int c) {
        LAS unsigned char* S_ = C.lds + O_TB + (c & 3) * TBSZ;
        LAS bf16_t* At = (LAS bf16_t*)(S_ + O_AT); LAS bf16_t* Rt = (LAS bf16_t*)(S_ + O_RT); LAS bf16_t* Bn = (LAS bf16_t*)(S_ + O_BN); LAS bf16_t* Kn = (LAS bf16_t*)(S_ + O_KN);
        const int wv = pt >> 3; float off[8] = {0.f, 0.f, 0.f, 0.f, 0.f, 0.f, 0.f, 0.f};
#pragma unroll
        for (int q = 0; q < 3; ++q) if (q < wv) { if (!RWKV) { off[0] += tot[(c & 1) * 256 + q * 64 + 8 * ps]; continue; }
            const f32x4 t0 = *(const LAS f32x4*)(tot + (c & 1) * 256 + q * 64 + 8 * ps), t1 = *(const LAS f32x4*)(tot + (c & 1) * 256 + q * 64 + 8 * ps + 4);
            off[0] += t0.x; off[1] += t0.y; off[2] += t0.z; off[3] += t0.w; off[4] += t1.x; off[5] += t1.y; off[6] += t1.z; off[7] += t1.w; }
        float at[8], rt[8], bt[8], kt[8], cl[8], vkk[8], vb[8], vk[8], vr[8]; unpack8(pkk, vkk); unpack8(pb, vb); unpack8(pk, vk); unpack8(pr, vr);
        if (!RWKV) {
            const float cI = vci[0] + off[0], cX = cI - vlw[0]; const float eI = __expf(cI), enI = __builtin_amdgcn_rcpf(eI), eX = __expf(cX);
#pragma unroll
            for (int e = 0; e < 8; ++e) { at[e] = vkk[e] * eX; rt[e] = vr[e] * eI; bt[e] = -vb[e] * enI; kt[e] = vk[e] * enI; cl[e] = eI; }
        } else
#pragma unroll
        for (int e = 0; e < 8; ++e) { const float cI = vci[e] + off[e], cX = cI - vlw[e]; const float eI = __expf(cI), enI = __expf(-cI), eX = __expf(cX);
            at[e] = vkk[e] * eX; rt[e] = vr[e] * eI; bt[e] = -vb[e] * enI; kt[e] = vk[e] * enI; cl[e] = eI; }
        *(LAS u32x4*)(At + pt * AP + 8 * ps) = pack8(at); *(LAS u32x4*)(Rt + pt * AP + 8 * ps) = pack8(rt);
        *(LAS u32x4*)(Bn + pt * AP + 8 * ps) = pack8(bt); *(LAS u32x4*)(Kn + pt * AP + 8 * ps) = pack8(kt);
        if (pt == CL - 1) { LAS float* cp = (LAS float*)(S_ + O_CL) + 8 * ps; *(LAS f32x4*)cp = (f32x4){cl[0], cl[1], cl[2], cl[3]}; *(LAS f32x4*)(cp + 4) = (f32x4){cl[4], cl[5], cl[6], cl[7]}; }
    };
    auto gram_tile = [&](int c, int tile, f32x16& g) {
        LAS unsigned char* S_ = C.lds + O_TB + (c & 3) * TBSZ;
        const LAS bf16_t* GA = (const LAS bf16_t*)(S_ + ((tile < 2) ? O_AT : O_RT)); const LAS bf16_t* GB = (const LAS bf16_t*)(S_ + ((tile & 1) ? O_KN : O_BN));
#pragma unroll
        for (int e = 0; e < 16; ++e) g[e] = 0.f;
#pragma unroll
        for (int ks = 0; ks < 4; ++ks) g = MFMA32(frag_contig(GA + r * AP + 16 * ks + 8 * hh), frag_contig(GB + r * AP + 16 * ks + 8 * hh), g);
    };
    auto put_tile = [&](LAS bf16_t* dst, const f32x16& g, bool strict) {
#pragma unroll
        for (int e = 0; e < 16; ++e) { const int t = crow(e, hh), s_ = r; const float val = (strict ? (s_ < t) : (s_ <= t)) ? g[e] : 0.f; dst[t * TP + s_] = (bf16_t)(cvtpk(val, 0.f) & 0xffffu); }
    };
    LAS f32x4* stp = (LAS f32x4*)(C.lds + O_ST);
    if (w == 7) {
#pragma unroll
        for (int q = 0; q < 8; ++q) stp[q * 64 + lane] = (f32x4){0.f, 0.f, 0.f, 0.f};
        if (lane == 0) *(volatile LAS int*)(C.lds + O_FLAG) = 0; }
    bf16_t* ydst = A.oab + (size_t)b * SEQ * DM + (RWKV ? 512 : 0) + h * 64 + 32 * half;
    if (w >= 4) __builtin_amdgcn_s_setprio(2);
    for (int j = 0; j < NCH + 3; ++j) {
        asm volatile("" : "+v"(lane));
        tid = w * 64 + lane; r = lane & 31; hh = lane >> 5; pt = (tid >> 3) & 31; ps = tid & 7; own = (ps >> 2) == half;
        const bool vecs = (w < 4) && (j < NCH), vecs3 = (w < 4) && (j >= 1) && (j <= NCH), gram = (w >= 4 && w < 7) && (j >= 2) && (j <= NCH + 1), seq = (w == 7) && (j >= 3);
        LAS unsigned char* TNw = C.lds + O_TN + ((j - 2) & 1) * TNSZ;
        if (vecs3) stage3(j - 1);
        if (vecs) { if (j == 0) issue(0); stage1(j); if (j + 1 < NCH) issue(j + 1); }
        if (gram && w == 6) {
            f32x16 g; gram_tile(j - 2, 0, g);
#pragma unroll
            for (int e = 0; e < 16; ++e) { const int t = crow(e, hh), s_ = r; const float nv = (s_ < t) ? -g[e] : 0.f; Nab[t * NP + s_] = nv;
                ((LAS bf16_t*)(TNw + O_NLO))[t * TP + s_] = (bf16_t)(cvtpk((t >= 16 && s_ < 16) ? -nv : 0.f, 0.f) & 0xffffu); }
            asm volatile("s_waitcnt lgkmcnt(0)" ::: "memory");
            *(volatile LAS int*)(C.lds + O_FLAG) = j;
        }
        if (!RWKV && (w == 5 || w == 6) && j < NCH) {
            if (j == 0) issue_v(0);
            const int idx = (w - 5) * 64 + lane, vt = idx >> 2, vg = idx & 3; float v8[8]; conv8(L2, 128 + 8 * vg, v8);
            *(LAS u32x4*)((LAS bf16_t*)(C.lds + O_TB + (j & 3) * TBSZ + O_V) + vt * 32 + 8 * vg) = pack8(v8);
            if (j + 1 < NCH) issue_v(j + 1);
        }
        if (gram) {
            f32x16 g;
            if (w == 4) { while (*(volatile LAS int*)(C.lds + O_FLAG) != j) __builtin_amdgcn_s_sleep(1);
                asm volatile("s_waitcnt lgkmcnt(0)" ::: "memory");
            {
            LAS bf16_t* Tm = (LAS bf16_t*)(TNw + O_TM); float Tr[16]; const int jb = (lane >> 4) & 1, jc = lane & 15;
            const LAS float* Nb = Nab + (16 * jb) * NP + 16 * jb;
#pragma unroll
            for (int i = 0; i < 16; ++i) { float a0 = (i == jc) ? 1.f : 0.f, a1 = 0.f, a2 = 0.f, a3 = 0.f;
#pragma unroll
                for (int k4 = 0; k4 < i; k4 += 4) { const f32x4 n4 = *(const LAS f32x4*)(Nb + i * NP + k4);
                    a0 -= n4.x * Tr[k4]; if (k4 + 1 < i) a1 -= n4.y * Tr[k4 + 1]; if (k4 + 2 < i) a2 -= n4.z * Tr[k4 + 2]; if (k4 + 3 < i) a3 -= n4.w * Tr[k4 + 3]; }
                Tr[i] = (a0 + a1) + (a2 + a3);
                if (hh == 0) { Tm[(16 * jb + i) * TP + 16 * jb + jc] = (bf16_t)(cvtpk(Tr[i], 0.f) & 0xffffu); Tm[(16 * jb + i) * TP + 16 * (1 - jb) + jc] = (bf16_t)0; } }
        }
            }
            else if (w == 5) { gram_tile(j - 2, 1, g); put_tile((LAS bf16_t*)(TNw + O_NAK), g, true); gram_tile(j - 2, 2, g); put_tile((LAS bf16_t*)(TNw + O_NBR), g, false); }
            else { gram_tile(j - 2, 3, g); put_tile((LAS bf16_t*)(TNw + O_NKR), g, false); }
        }
        if (seq) {
            const int c = j - 3; LAS unsigned char* Q_ = C.lds + O_TB + (c & 3) * TBSZ; LAS unsigned char* R_ = C.lds + O_TN + (c & 1) * TNSZ;
            LAS bf16_t* qAt = (LAS bf16_t*)(Q_ + O_AT); LAS bf16_t* qRt = (LAS bf16_t*)(Q_ + O_RT); LAS bf16_t* qnBn = (LAS bf16_t*)(Q_ + O_BN); LAS bf16_t* qKn = (LAS bf16_t*)(Q_ + O_KN);
            LAS bf16_t* qV = (LAS bf16_t*)(Q_ + O_V); LAS float* qcL = (LAS float*)(Q_ + O_CL);
            LAS bf16_t* qTm = (LAS bf16_t*)(R_ + O_TM); LAS bf16_t* qNlo = (LAS bf16_t*)(R_ + O_NLO); LAS bf16_t* qNak = (LAS bf16_t*)(R_ + O_NAK); LAS bf16_t* qNbr = (LAS bf16_t*)(R_ + O_NBR); LAS bf16_t* qNkr = (LAS bf16_t*)(R_ + O_NKR);
            f32x16 X, D, Y, E, St[2]; bf16x8 vf[2];
#pragma unroll
            for (int i = 0; i < 2; ++i)
#pragma unroll
                for (int q = 0; q < 4; ++q) { const f32x4 t4 = stp[(4 * i + q) * 64 + lane]; St[i][4 * q] = t4.x; St[i][4 * q + 1] = t4.y; St[i][4 * q + 2] = t4.z; St[i][4 * q + 3] = t4.w; }
#pragma unroll
            for (int ks = 0; ks < 2; ++ks) vf[ks] = frag_tr(qV, 32, 16 * ks, 0, lane);
#pragma unroll
            for (int e = 0; e < 16; ++e) { X[e] = 0.f; D[e] = 0.f; Y[e] = 0.f; E[e] = 0.f; }
#pragma unroll
            for (int i = 0; i < 2; ++i)
#pragma unroll
                for (int s = 0; s < 2; ++s) { const bf16x8 sb = pack_step(St[i], s);
                    X = MFMA32(frag_perm(qAt + r * AP + 32 * i + 16 * s + 4 * hh), sb, X);
                    Y = MFMA32(frag_perm(qRt + r * AP + 32 * i + 16 * s + 4 * hh), sb, Y); }
#pragma unroll
            for (int ks = 0; ks < 2; ++ks) { X = MFMA32(frag_contig(qNak + r * TP + 16 * ks + 8 * hh), vf[ks], X); Y = MFMA32(frag_contig(qNkr + r * TP + 16 * ks + 8 * hh), vf[ks], Y); }
#pragma unroll
            for (int s = 0; s < 2; ++s) D = MFMA32(frag_perm(qTm + r * TP + 16 * s + 4 * hh), pack_step(X, s), D);
#pragma unroll
            for (int s = 0; s < 2; ++s) E = MFMA32(frag_perm(qNlo + r * TP + 16 * s + 4 * hh), pack_step(D, s), E);
#pragma unroll
            for (int s = 0; s < 2; ++s) D = MFMA32(frag_perm(qTm + r * TP + 16 * s + 4 * hh), pack_step(E, s), D);
#pragma unroll
            for (int s = 0; s < 2; ++s) { const bf16x8 db = pack_step(D, s);
                Y = MFMA32(frag_perm(qNbr + r * TP + 16 * s + 4 * hh), db, Y);
#pragma unroll
                for (int i = 0; i < 2; ++i) St[i] = MFMA32(frag_tr_perm(qnBn, AP, s, 32 * i, lane), db, St[i]); }
#pragma unroll
            for (int i = 0; i < 2; ++i) {
#pragma unroll
                for (int ks = 0; ks < 2; ++ks) St[i] = MFMA32(frag_tr(qKn, AP, 16 * ks, 32 * i, lane), vf[ks], St[i]);
#pragma unroll
                for (int e = 0; e < 16; ++e) St[i][e] *= qcL[32 * i + crow(e, hh)];
#pragma unroll
                for (int q = 0; q < 4; ++q) stp[(4 * i + q) * 64 + lane] = (f32x4){St[i][4 * q], St[i][4 * q + 1], St[i][4 * q + 2], St[i][4 * q + 3]}; }
            bf16_t* yp = ydst + (size_t)c * CL * DM + r;
#pragma unroll
            for (int e = 0; e < 16; ++e) yp[(size_t)crow(e, hh) * DM] = (bf16_t)(cvtpk(Y[e], 0.f) & 0xffffu);
        }
        CK_BAR();
    }
    __builtin_amdgcn_s_setprio(0);
}

template <bool PRE>
DI void ret_unit(const Ctx& C, bf16_t* p1, float* SEG, const float* gnw, int bh, int seg) {
    const int lane = lane_id(), tid = C.wave * 64 + lane, w = C.wave, r = lane & 31, hh = lane >> 5, d0 = 32 * w;
    const int b = bh >> 3, h = bh & 7;
    LAS bf16_t* Qs = (LAS bf16_t*)(C.lds + L_Q); LAS bf16_t* Ks = (LAS bf16_t*)(C.lds + L_K); LAS bf16_t* Kd = (LAS bf16_t*)(C.lds + L_KD);
    LAS bf16_t* Vs = (LAS bf16_t*)(C.lds + L_V); LAS bf16_t* Ps = (LAS bf16_t*)(C.lds + L_P); LAS float* Os = (LAS float*)(C.lds + 512);
    const float lg2 = log2f(1.0f - exp2f(-5.0f - (float)h));
    const float g64 = exp2f(lg2 * 64.f);
    LAS float* gtab = (LAS float*)(C.lds + L_GT);
    __syncthreads();
    if (tid <= 64) gtab[tid] = exp2f(lg2 * (float)tid);
    LAS float* gls = (LAS float*)(C.lds + RING_BYTES + 1024);
    if (!PRE && tid < 256) gls[tid] = gnw[h * 256 + tid];
    __syncthreads();
    f32x16 St[4];
#pragma unroll
    for (int i = 0; i < 4; ++i)
#pragma unroll
        for (int e = 0; e < 16; ++e) St[i][e] = 0.f;
    if (!PRE) {
        for (int sp = 0; sp < seg; ++sp) {
            const float f = exp2f(lg2 * (float)(RSEGLEN * (seg - 1 - sp)));
            const float* src = SEG + ((size_t)(bh * 3 + sp) * 8 + w) * 4096 + lane;
#pragma unroll
            for (int i = 0; i < 4; ++i)
#pragma unroll
                for (int e = 0; e < 16; ++e) St[i][e] += f * src[(i * 16 + e) * 64];
        }
    }
    u32x4 rq[2], rk[2], rv[4];
    auto gload = [&](int ch) {
        const size_t tt = (size_t)bh * SEQ, t0 = (size_t)seg * RSEGLEN + ch * RC;
#pragma unroll
        for (int i = 0; i < 2; ++i) { const int item = tid + 512 * i;
            if (!PRE) rq[i] = *(const u32x4*)(p1 + P1_Q + (tt + t0) * 128 + (size_t)item * 8);
            rk[i] = *(const u32x4*)(p1 + P1_K + (tt + t0) * 128 + (size_t)item * 8); }
#pragma unroll
        for (int i = 0; i < 4; ++i) { const int item = tid + 512 * i; rv[i] = *(const u32x4*)(p1 + P1_V + (tt + t0) * 256 + (size_t)item * 8); }
    };
    gload(0);
    for (int ch = 0; ch < RSEGLEN / RC; ++ch) {
        const size_t m0 = (size_t)b * SEQ + seg * RSEGLEN + ch * RC;
#pragma unroll
        for (int i = 0; i < 2; ++i) { const int item = tid + 512 * i, j = item >> 4, c = item & 15;
            if (!PRE) { *(LAS u32x4*)(Qs + j * QP + 8 * c) = rq[i]; *(LAS u32x4*)(Ks + j * QP + 8 * c) = rk[i]; }
            float kf[8]; unpack8(rk[i], kf); const float f = gtab[RC - 1 - j];
#pragma unroll
            for (int e = 0; e < 8; ++e) kf[e] *= f;
            *(LAS u32x4*)(Kd + j * KDP + 8 * c) = pack8(kf); }
#pragma unroll
        for (int i = 0; i < 4; ++i) { const int item = tid + 512 * i, j = item >> 5, c = item & 31; *(LAS u32x4*)(Vs + j * VP + 8 * c) = rv[i]; }
        __syncthreads();
        if (ch + 1 < RSEGLEN / RC) gload(ch + 1);
        u32x4 rg[4];
        if (!PRE) { const bf16_t* gp0 = p1 + P1_G + (m0 + (tid >> 3)) * 2048 + h * 256 + 32 * (tid & 7);
#pragma unroll
            for (int q4 = 0; q4 < 2; ++q4) rg[q4] = *(const u32x4*)(gp0 + 8 * q4); }
        f32x16 Ot[2];
        if (!PRE) {
            if (w < 4) {
                const int qi = w >> 1, ji = w & 1; f32x16 sc;
#pragma unroll
                for (int e = 0; e < 16; ++e) sc[e] = 0.f;
                if (qi >= ji) {
#pragma unroll
                    for (int ks = 0; ks < 8; ++ks) { sc = MFMA32(frag_contig(Qs + (32 * qi + r) * QP + 16 * ks + 8 * hh), frag_contig(Ks + (32 * ji + r) * QP + 16 * ks + 8 * hh), sc); if (ks & 1) __builtin_amdgcn_sched_barrier(0); }
                }
#pragma unroll
                for (int e = 0; e < 16; ++e) { const int q = 32 * qi + crow(e, hh), j = 32 * ji + r; const float val = (q >= j) ? sc[e] * gtab[q >= j ? q - j : 0] : 0.f;
                    Ps[q * PP + j] = (bf16_t)(cvtpk(val, 0.f) & 0xffffu); }
            }
#pragma unroll
            for (int qi = 0; qi < 2; ++qi)
#pragma unroll
                for (int e = 0; e < 16; ++e) Ot[qi][e] = 0.f;
#pragma unroll
            for (int i = 0; i < 4; ++i)
#pragma unroll
                for (int s = 0; s < 2; ++s) { const bf16x8 sb = pack_step(St[i], s);
#pragma unroll
                    for (int qi = 0; qi < 2; ++qi) Ot[qi] = MFMA32(frag_perm(Qs + (32 * qi + r) * QP + 32 * i + 16 * s + 4 * hh), sb, Ot[qi]);
                    __builtin_amdgcn_sched_barrier(0); }
#pragma unroll
            for (int qi = 0; qi < 2; ++qi)
#pragma unroll
                for (int e = 0; e < 16; ++e) Ot[qi][e] *= gtab[32 * qi + crow(e, hh) + 1];
            __syncthreads();
#pragma unroll 1
            for (int ks = 0; ks < 4; ++ks) { const bf16x8 vb = frag_tr(Vs, VP, 16 * ks, d0, lane);
#pragma unroll
                for (int qi = 0; qi < 2; ++qi) Ot[qi] = MFMA32(frag_contig(Ps + (32 * qi + r) * PP + 16 * ks + 8 * hh), vb, Ot[qi]); }
        }
#pragma unroll
        for (int i = 0; i < 4; ++i)
#pragma unroll
            for (int e = 0; e < 16; ++e) St[i][e] *= g64;
#pragma unroll 1
        for (int ks = 0; ks < 4; ++ks) { const bf16x8 vb = frag_tr(Vs, VP, 16 * ks, d0, lane);
#pragma unroll
            for (int i = 0; i < 4; ++i) St[i] = MFMA32(frag_tr(Kd, KDP, 16 * ks, 32 * i, lane), vb, St[i]); }
        __syncthreads();
        if (!PRE) {
            __builtin_amdgcn_sched_barrier(0);
#pragma unroll
            for (int qi = 0; qi < 2; ++qi)
#pragma unroll
                for (int e = 0; e < 16; ++e) Os[(32 * qi + crow(e, hh)) * OSP + d0 + r] = Ot[qi][e];
            __syncthreads();
            {
                const int row = tid >> 3, sg = tid & 7; const LAS float* orow = Os + row * OSP + 32 * sg; float s1 = 0.f, s2 = 0.f;
                { const bf16_t* gp0 = p1 + P1_G + (m0 + row) * 2048 + h * 256 + 32 * sg; rg[2] = *(const u32x4*)(gp0 + 16); rg[3] = *(const u32x4*)(gp0 + 24); }
#pragma unroll
                for (int e = 0; e < 32; e += 4) { const f32x4 t4 = *(const LAS f32x4*)(orow + e); s1 += (t4.x + t4.y) + (t4.z + t4.w); s2 += (t4.x * t4.x + t4.y * t4.y) + (t4.z * t4.z + t4.w * t4.w); }
                const float mean = red8(s1) * (1.f / 256.f); const float var = fmaxf(red8(s2) * (1.f / 256.f) - mean * mean, 0.f);
                const float rstd = __builtin_amdgcn_rsqf(var + 1e-6f);
                bf16_t* gp = p1 + P1_G + (m0 + row) * 2048 + h * 256 + 32 * sg; const LAS float* gw = gls + 32 * sg;
#pragma unroll
                for (int q4 = 0; q4 < 4; ++q4) { float gg[8]; unpack8(rg[q4], gg); float o[8];
                    const f32x4 ya = *(const LAS f32x4*)(orow + 8 * q4), yb = *(const LAS f32x4*)(orow + 8 * q4 + 4); const float yv[8] = {ya.x, ya.y, ya.z, ya.w, yb.x, yb.y, yb.z, yb.w};
#pragma unroll
                    for (int e = 0; e < 8; ++e) o[e] = siluf_(gg[e]) * ((yv[e] - mean) * rstd * gw[8 * q4 + e]);
                    *(u32x4*)(gp + 8 * q4) = pack8(o); }
            }
            __syncthreads();
        }
    }
    if (PRE) {
        float* dst = SEG + ((size_t)(bh * 3 + seg) * 8 + w) * 4096 + lane;
#pragma unroll
        for (int i = 0; i < 4; ++i)
#pragma unroll
            for (int e = 0; e < 16; ++e) dst[(i * 16 + e) * 64] = St[i][e];
    }
}


constexpr int RP_BUF = RC * KDP * 2 + RC * VP * 2;
static_assert(512 + 2 * RP_BUF <= RING_BYTES, "retention pre-pass LDS");
DI void ret_pre(const Ctx& C, const bf16_t* p1, float* SEG, int bh, int seg) {
    const int lane = lane_id(), w = C.wave, tid = w * 64 + lane, d0 = 32 * w, h = bh & 7;
    LAS float* gtab = (LAS float*)(C.lds + L_GT);
    const float lg2 = log2f(1.0f - exp2f(-5.0f - (float)h)); const float g64 = exp2f(lg2 * 64.f);
    constexpr int NCHK = RSEGLEN / RC;
    __syncthreads();
    if (tid <= 64) gtab[tid] = exp2f(lg2 * (float)tid);
    __syncthreads();
    f32x16 St[4];
#pragma unroll
    for (int i = 0; i < 4; ++i)
#pragma unroll
        for (int e = 0; e < 16; ++e) St[i][e] = 0.f;
    const size_t tt = (size_t)bh * SEQ + (size_t)seg * RSEGLEN;
    u32x4 rkA[2], rvA[4], rkB[2], rvB[4];
    auto gload = [&](u32x4* rk, u32x4* rv, int c) {
#pragma unroll
        for (int i = 0; i < 2; ++i) rk[i] = *(const u32x4*)(p1 + P1_K + (tt + c * RC) * 128 + (size_t)(tid + 512 * i) * 8);
#pragma unroll
        for (int i = 0; i < 4; ++i) rv[i] = *(const u32x4*)(p1 + P1_V + (tt + c * RC) * 256 + (size_t)(tid + 512 * i) * 8);
    };
    auto stage = [&](const u32x4* rk, const u32x4* rv, int buf) {
        LAS bf16_t* Kd = (LAS bf16_t*)(C.lds + 512 + buf * RP_BUF); LAS bf16_t* Vs = Kd + RC * KDP;
#pragma unroll
        for (int i = 0; i < 2; ++i) { const int item = tid + 512 * i, j = item >> 4, c = item & 15; float kf[8]; unpack8(rk[i], kf); const float f = gtab[RC - 1 - j];
#pragma unroll
            for (int e = 0; e < 8; ++e) kf[e] *= f;
            *(LAS u32x4*)(Kd + j * KDP + 8 * c) = pack8(kf); }
#pragma unroll
        for (int i = 0; i < 4; ++i) { const int item = tid + 512 * i, j = item >> 5, c = item & 31; *(LAS u32x4*)(Vs + j * VP + 8 * c) = rv[i]; }
    };
    auto state = [&](int buf) {
        const LAS bf16_t* Kd = (const LAS bf16_t*)(C.lds + 512 + buf * RP_BUF); const LAS bf16_t* Vs = Kd + RC * KDP;
#pragma unroll
        for (int i = 0; i < 4; ++i)
#pragma unroll
            for (int e = 0; e < 16; ++e) St[i][e] *= g64;
#pragma unroll
        for (int ks = 0; ks < 4; ++ks) { const bf16x8 vb = frag_tr(Vs, VP, 16 * ks, d0, lane);
#pragma unroll
            for (int i = 0; i < 4; ++i) St[i] = MFMA32(frag_tr(Kd, KDP, 16 * ks, 32 * i, lane), vb, St[i]); }
    };
    gload(rkA, rvA, 0); gload(rkB, rvB, 1);
    stage(rkA, rvA, 0); gload(rkA, rvA, 2);
    __syncthreads();
#pragma unroll 1
    for (int c = 0; c < NCHK; c += 2) {
        if (c + 1 < NCHK) { stage(rkB, rvB, 1); if (c + 3 < NCHK) gload(rkB, rvB, c + 3); }
        state(0);
        __syncthreads();
        if (c + 2 < NCHK) { stage(rkA, rvA, 0); if (c + 4 < NCHK) gload(rkA, rvA, c + 4); }
        if (c + 1 < NCHK) state(1);
        __syncthreads();
    }
    float* dst = SEG + ((size_t)(bh * 3 + seg) * 8 + w) * 4096 + lane;
#pragma unroll
    for (int i = 0; i < 4; ++i)
#pragma unroll
        for (int e = 0; e < 16; ++e) dst[(i * 16 + e) * 64] = St[i][e];
}

constexpr int M_GI = 512, M_Q = 1024, M_KD = M_Q + RC * QP * 2, M_V = M_KD + RC * KDP * 2, M_P = M_V + RC * VP * 2, M_O = M_P + RC * PP * 2, MOSP = 264, M_END = M_O + RC * MOSP * 2;
static_assert(M_END <= RING_BYTES, "retention main-pass LDS");
DI void ret_main(const Ctx& C, bf16_t* p1, const float* SEG, const float* gnw, int bh, int seg) {
    const int lane = lane_id(), w = C.wave, tid = w * 64 + lane, r = lane & 31, hh = lane >> 5;
    const int b = bh >> 3, h = bh & 7;
    LAS bf16_t* Qs = (LAS bf16_t*)(C.lds + M_Q); LAS bf16_t* Kd = (LAS bf16_t*)(C.lds + M_KD); LAS bf16_t* Vs = (LAS bf16_t*)(C.lds + M_V);
    LAS bf16_t* Ps = (LAS bf16_t*)(C.lds + M_P); LAS bf16_t* Os = (LAS bf16_t*)(C.lds + M_O);
    LAS float* gtab = (LAS float*)(C.lds + L_GT); LAS float* ginv = (LAS float*)(C.lds + M_GI); LAS float* gls = (LAS float*)(C.lds + RING_BYTES + 1024);
    const float lg2 = log2f(1.0f - exp2f(-5.0f - (float)h)); const float g64 = exp2f(lg2 * 64.f);
    constexpr int NCHK = RSEGLEN / RC;
    __syncthreads();
    if (tid <= 64) gtab[tid] = exp2f(lg2 * (float)tid);
    if (tid < 64) ginv[tid] = exp2f(-lg2 * (float)tid);
    if (tid < 256) gls[tid] = gnw[h * 256 + tid];
    __syncthreads();
    if (w < 4) {
        __builtin_amdgcn_s_setprio(2);
        const int d0 = 64 * w; f32x16 St[4][2];
#pragma unroll
        for (int i = 0; i < 4; ++i)
#pragma unroll
            for (int cj = 0; cj < 2; ++cj)
#pragma unroll
                for (int e = 0; e < 16; ++e) St[i][cj][e] = 0.f;
        for (int sp = 0; sp < seg; ++sp) { const float f = exp2f(lg2 * (float)(RSEGLEN * (seg - 1 - sp)));
#pragma unroll
            for (int cj = 0; cj < 2; ++cj) { const float* src = SEG + ((size_t)(bh * 3 + sp) * 8 + 2 * w + cj) * 4096 + lane;
#pragma unroll
                for (int i = 0; i < 4; ++i)
#pragma unroll
                    for (int e = 0; e < 16; ++e) St[i][cj][e] += f * src[(i * 16 + e) * 64]; } }
        __syncthreads();
#pragma unroll 1
        for (int c = 0; c < NCHK; ++c) {
            { const int qi = w >> 1, ji = w & 1; f32x16 sc;
#pragma unroll
                for (int e = 0; e < 16; ++e) sc[e] = 0.f;
                if (qi >= ji) {
#pragma unroll
                    for (int ks = 0; ks < 8; ++ks) sc = MFMA32(frag_contig(Qs + (32 * qi + r) * QP + 16 * ks + 8 * hh), frag_contig(Kd + (32 * ji + r) * KDP + 16 * ks + 8 * hh), sc);
                }
#pragma unroll
                for (int e = 0; e < 16; ++e) { const int q = 32 * qi + crow(e, hh), j = 32 * ji + r; const float val = (q >= j) ? sc[e] * ginv[63 - q] : 0.f;
                    Ps[q * PP + j] = (bf16_t)(cvtpk(val, 0.f) & 0xffffu); } }
            f32x16 Ot[2][2];
#pragma unroll
            for (int qi = 0; qi < 2; ++qi)
#pragma unroll
                for (int cj = 0; cj < 2; ++cj)
#pragma unroll
                    for (int e = 0; e < 16; ++e) Ot[qi][cj][e] = 0.f;
#pragma unroll
            for (int i = 0; i < 4; ++i)
#pragma unroll
                for (int s_ = 0; s_ < 2; ++s_) { const bf16x8 sb0 = pack_step(St[i][0], s_), sb1 = pack_step(St[i][1], s_);
#pragma unroll
                    for (int qi = 0; qi < 2; ++qi) { const bf16x8 a = frag_perm(Qs + (32 * qi + r) * QP + 32 * i + 16 * s_ + 4 * hh);
                        Ot[qi][0] = MFMA32(a, sb0, Ot[qi][0]); Ot[qi][1] = MFMA32(a, sb1, Ot[qi][1]); } }
#pragma unroll
            for (int qi = 0; qi < 2; ++qi)
#pragma unroll
                for (int e = 0; e < 16; ++e) { const float gq = gtab[32 * qi + crow(e, hh) + 1]; Ot[qi][0][e] *= gq; Ot[qi][1][e] *= gq; }
            __syncthreads();
#pragma unroll
            for (int i = 0; i < 4; ++i)
#pragma unroll
                for (int cj = 0; cj < 2; ++cj)
#pragma unroll
                    for (int e = 0; e < 16; ++e) St[i][cj][e] *= g64;
#pragma unroll 1
            for (int ks = 0; ks < 4; ++ks) { const bf16x8 vb0 = frag_tr(Vs, VP, 16 * ks, d0, lane), vb1 = frag_tr(Vs, VP, 16 * ks, d0 + 32, lane);
#pragma unroll
                for (int qi = 0; qi < 2; ++qi) { const bf16x8 a = frag_contig(Ps + (32 * qi + r) * PP + 16 * ks + 8 * hh); Ot[qi][0] = MFMA32(a, vb0, Ot[qi][0]); Ot[qi][1] = MFMA32(a, vb1, Ot[qi][1]); }
#pragma unroll
                for (int i = 0; i < 4; ++i) { const bf16x8 a = frag_tr(Kd, KDP, 16 * ks, 32 * i, lane); St[i][0] = MFMA32(a, vb0, St[i][0]); St[i][1] = MFMA32(a, vb1, St[i][1]); } }
            __syncthreads();
#pragma unroll
            for (int qi = 0; qi < 2; ++qi)
#pragma unroll
                for (int cj = 0; cj < 2; ++cj)
#pragma unroll
                    for (int e = 0; e < 16; ++e) Os[(32 * qi + crow(e, hh)) * MOSP + d0 + 32 * cj + r] = (bf16_t)(cvtpk(Ot[qi][cj][e], 0.f) & 0xffffu);
            __syncthreads();
        }
        __builtin_amdgcn_s_setprio(0);
        __syncthreads();
    } else {
        const int st = tid - 256; const size_t tt = (size_t)bh * SEQ + (size_t)seg * RSEGLEN;
        const size_t m00 = (size_t)b * SEQ + (size_t)seg * RSEGLEN;
        u32x4 rq[4], rk[4], rvA[8], rvB[8], rg[8];
        auto gload = [&](int c) {
#pragma unroll
            for (int i = 0; i < 4; ++i) { const size_t it = (size_t)(st + 256 * i) * 8; rq[i] = *(const u32x4*)(p1 + P1_Q + (tt + c * RC) * 128 + it); rk[i] = *(const u32x4*)(p1 + P1_K + (tt + c * RC) * 128 + it); }
        };
        auto vload = [&](u32x4* rv, int c) {
#pragma unroll
            for (int i = 0; i < 8; ++i) rv[i] = *(const u32x4*)(p1 + P1_V + (tt + c * RC) * 256 + (size_t)(st + 256 * i) * 8);
        };
        auto stage = [&](const u32x4* rv) {
#pragma unroll
            for (int i = 0; i < 4; ++i) { const int item = st + 256 * i, j = item >> 4, cc = item & 15;
                *(LAS u32x4*)(Qs + j * QP + 8 * cc) = rq[i];
                float kf[8]; unpack8(rk[i], kf); const float f = gtab[RC - 1 - j];
#pragma unroll
                for (int e = 0; e < 8; ++e) kf[e] *= f;
                *(LAS u32x4*)(Kd + j * KDP + 8 * cc) = pack8(kf); }
#pragma unroll
            for (int i = 0; i < 8; ++i) { const int item = st + 256 * i, j = item >> 5, cc = item & 31; *(LAS u32x4*)(Vs + j * VP + 8 * cc) = rv[i]; }
        };
        const int row = st >> 2, sq = st & 3;
        auto gate_load = [&](int c) { const bf16_t* gp0 = p1 + P1_G + (m00 + c * RC + row) * 2048 + h * 256 + 64 * sq;
#pragma unroll
            for (int q8 = 0; q8 < 8; ++q8) rg[q8] = *(const u32x4*)(gp0 + 8 * q8); };
        float mean = 0.f, rstd = 0.f;
        auto epi_stats = [&]() { const LAS bf16_t* orow = Os + row * MOSP + 64 * sq; float s1 = 0.f, s2 = 0.f;
#pragma unroll
            for (int q8 = 0; q8 < 8; ++q8) { float t[8]; unpack8(*(const LAS u32x4*)(orow + 8 * q8), t);
#pragma unroll
                for (int k = 0; k < 8; ++k) { s1 += t[k]; s2 += t[k] * t[k]; } }
            s1 += dppmov<0xB1>(s1); s1 += dppmov<0x4E>(s1); s2 += dppmov<0xB1>(s2); s2 += dppmov<0x4E>(s2);
            mean = s1 * (1.f / 256.f); const float var = fmaxf(s2 * (1.f / 256.f) - mean * mean, 0.f); rstd = __builtin_amdgcn_rsqf(var + 1e-6f); };
        auto epi_out = [&](int c, int q0) { const LAS bf16_t* orow = Os + row * MOSP + 64 * sq; const LAS float* gw = gls + 64 * sq;
            bf16_t* gp = p1 + P1_G + (m00 + c * RC + row) * 2048 + h * 256 + 64 * sq;
#pragma unroll
            for (int q8 = q0; q8 < q0 + 4; ++q8) { float gg[8], yv[8], o[8]; unpack8(rg[q8], gg); unpack8(*(const LAS u32x4*)(orow + 8 * q8), yv);
#pragma unroll
                for (int e = 0; e < 8; ++e) o[e] = siluf_(gg[e]) * ((yv[e] - mean) * rstd * gw[8 * q8 + e]);
                *(u32x4*)(gp + 8 * q8) = pack8(o); } };
        gload(0); vload(rvA, 0); vload(rvB, 1); stage(rvA); gload(1); vload(rvA, 2);
        __syncthreads();
#pragma unroll 1
        for (int c = 0; c < NCHK; c += 2) {
            if (c > 0) { epi_stats(); epi_out(c - 1, 0); }
            __syncthreads();
            if (c > 0) epi_out(c - 1, 4);
            __syncthreads();
            stage(rvB); if (c + 2 < NCHK) gload(c + 2); if (c + 3 < NCHK) vload(rvB, c + 3);
            gate_load(c);
            __syncthreads();
            epi_stats(); epi_out(c, 0);
            __syncthreads();
            epi_out(c, 4);
            __syncthreads();
            if (c + 2 < NCHK) { stage(rvA); if (c + 3 < NCHK) gload(c + 3); if (c + 4 < NCHK) vload(rvA, c + 4); }
            gate_load(c + 1);
            __syncthreads();
        }
        epi_stats(); epi_out(NCHK - 1, 0); epi_out(NCHK - 1, 4);
        __syncthreads();
    }
}

constexpr int NPHASE = 19;
struct Args { const float* in[27]; float* out; unsigned char* ws; int ph_lo, ph_hi; };
__global__ void __launch_bounds__(512, 2) fwd_kernel(Args args) {
    extern __shared__ __attribute__((aligned(16))) unsigned char lds_raw[];
    Ctx C; C.lds = (LAS unsigned char*)lds_raw; C.wave = __builtin_amdgcn_readfirstlane((int)threadIdx.x >> 6);
    C.G = gridDim.x; { const int bx = blockIdx.x; C.vcu = (C.G % 8 == 0) ? (bx % 8) * (C.G / 8) + bx / 8 : bx; }
    unsigned char* ws = args.ws; const float* const* in = args.in;
    volatile LAS unsigned* MISC = (volatile LAS unsigned*)(C.lds + MISC_OFF);
    for (int u = (int)threadIdx.x; u < (LDS_BYTES - RING_BYTES) / 4; u += 512) ((LAS unsigned*)(C.lds + RING_BYTES))[u] = 0u;
    __syncthreads();
#if MK_PER_PHASE
#define GRID_BAR() do { } while (0)
#else
    XcdBarrier bar = xcd_barrier_post((unsigned*)(ws + WS_CTL) + 1024, MISC + 8);
#define GRID_BAR() xcd_barrier(bar)
#endif
    const int lo = args.ph_lo, hi = args.ph_hi;
#ifndef PH_MASK
#define PH_MASK 0x7ffff
#endif
#define IN(k) (((PH_MASK >> (k)) & 1) && lo <= (k) && (k) < hi)
#define SEAM(k) do { if (IN(k) && IN((k) + 1)) GRID_BAR(); } while (0)
    bf16_t* U = (bf16_t*)(ws + R_U);
    bf16_t* HB = (bf16_t*)(ws + WS_HB); float* RS = (float*)(ws + WS_RS);
    float* H = args.out;
    const int bx = (int)blockIdx.x;

    if (IN(0)) { p_prologue(C, in, ws); } SEAM(0);
    if (IN(1)) { pg8::Gemm g{U, (const bf16_t*)(ws + W_IN0), MTOK, AB_PAD, DM, DM}; pg8::StaticOrder S; S.init(MTOK, AB_PAD, C.G, bx);
        pg8::Epi<FStoreRs> E{{(bf16_t*)(ws + R_A), AB_PAD, RS}}; pg8::gemm_phase<false>(C.lds, C.wave, g, S, E); } SEAM(1);
    if (IN(2)) { p_lora_pre(C, (const bf16_t*)(ws + R_A), in[12], (bf16_t*)(ws + WS_AP)); } SEAM(2);
    if (IN(3)) { pg8::Gemm g{(const bf16_t*)(ws + WS_AP), (const bf16_t*)(ws + W_LORA), MTOK, 1536, 256, 256}; pg8::StaticOrder S; S.init(MTOK, 1536, C.G, bx);
        pg8::Epi<FLora> E{{(bf16_t*)(ws + WS_LW), (bf16_t*)(ws + WS_AA), (bf16_t*)(ws + WS_GT), in[13], in[15]}}; pg8::gemm_phase<false>(C.lds, C.wave, g, S, E); } SEAM(3);
    ScanArgs SA{(const bf16_t*)(ws + R_A), U, (bf16_t*)(ws + WS_AP), in[8], in[9], in[10], in[11], in[12], in[18], in[19], in[20], in[21], in[22], (const bf16_t*)(ws + WS_LW), (const bf16_t*)(ws + WS_AA), (const bf16_t*)(ws + WS_GT)};
    if (IN(4)) {
        for (int task = bx; task < 256; task += C.G) { const int bh = (task >> 1) & 63, half = task >> 7;
            if (task & 1) chunk_task<true>(C, SA, bh >> 3, bh & 7, half); else chunk_task<false>(C, SA, bh >> 3, bh & 7, half);
            __syncthreads();
            const int nsl = (task & 1) ? WT_RW : WT_GD, g0 = ((task >> 1) * 8 + C.wave) * (WT_RW + WT_GD) + ((task & 1) ? 0 : WT_RW);
#pragma unroll 1
            for (int sl = 0; sl < nsl; ++sl) p_weights(C, in, ws, 1, 8, true, g0 + sl, 128 * 8 * (WT_RW + WT_GD));
            __syncthreads(); }
    } SEAM(4);
    if (IN(18)) { p_mix_post(C, SA); } if (IN(18) && IN(5)) GRID_BAR();
    if (IN(5)) { pg8::Gemm g{U, (const bf16_t*)(ws + W_OUT0), MTOK, DM, DM, DM}; pg8::StaticOrder S; S.init(MTOK, DM, C.G, bx);
        pg8::Epi<FStore> E{{(bf16_t*)(ws + R_B), DM}}; pg8::gemm_phase<false>(C.lds, C.wave, g, S, E); } SEAM(5);
    constexpr bool QUP0 = (Q8_MASK >> 2) & 1, QUP1 = (Q8_MASK >> 6) & 1;
    if (IN(6)) { p_norm(C, in[0], nullptr, (const bf16_t*)(ws + R_B), in[2], HB, nullptr, RS, QUP0 ? (signed char*)(ws + R_U) : nullptr); } SEAM(6);
    if (IN(7)) { pg8::StaticOrder S; S.init(MTOK, FF, C.G, bx);
        if (QUP0) { pg8::Gemm g{(const bf16_t*)(ws + R_U), (const bf16_t*)(ws + W_UP0), MTOK, FF, DM / 2, DM / 2}; pg8::Epi<FRelu2> E{{(bf16_t*)(ws + R_A), FF, RS, (const float*)(ws + WS_SW) + 1 * 6144}}; pg8::gemm_phase<true>(C.lds, C.wave, g, S, E); }
        else { pg8::Gemm g{HB, (const bf16_t*)(ws + W_UP0), MTOK, FF, DM, DM}; pg8::Epi<FRelu2> E{{(bf16_t*)(ws + R_A), FF, RS, nullptr}}; pg8::gemm_phase<false>(C.lds, C.wave, g, S, E); } } SEAM(7);
    if (IN(8)) { pg8::Gemm g{(const bf16_t*)(ws + R_A), (const bf16_t*)(ws + W_DN0), MTOK, DM, FF, FF}; pg8::StaticOrder S; S.init(MTOK, DM, C.G, bx, 1);
        pg8::Epi<FStore> E{{(bf16_t*)(ws + R_B), DM}}; pg8::gemm_phase<false>(C.lds, C.wave, g, S, E); } SEAM(8);
    if (IN(9)) { p_norm(C, nullptr, HB, (const bf16_t*)(ws + R_B), in[4], HB, nullptr, RS, (signed char*)H); } SEAM(9);
    bf16_t* P1 = (bf16_t*)(ws + R_U);
    float* SEGP = (float*)H; bf16_t* MIX1 = (bf16_t*)((unsigned char*)H + 64 * MiB);
    if (IN(10)) { pg8::Gemm g{(const bf16_t*)H, (const bf16_t*)(ws + W_IN1), MTOK, RET_IN, DM / 2, DM / 2}; pg8::StaticOrder S; S.init(MTOK, RET_IN, C.G, bx);
        pg8::Epi<FRotary> E{{P1, (const f32x2*)(ws + WS_ROT), RS, (const float*)(ws + WS_SW) + 2 * 6144}}; pg8::gemm_phase<true>(C.lds, C.wave, g, S, E); } SEAM(10);
    if (IN(11)) { for (int unit = bx; unit < 256; unit += C.G) { const int bh = unit >> 2, seg = unit & 3; if (seg < 3) ret_pre(C, P1, SEGP, bh, seg); } } SEAM(11);
    if (IN(12)) { for (int unit = bx; unit < 256; unit += C.G) { const int bh = unit >> 2, seg = unit & 3; ret_main(C, P1, SEGP, in[25], bh, seg); } } SEAM(12);
    if (IN(13)) { pg8::Gemm g{P1 + P1_G, (const bf16_t*)(ws + W_OUT1), MTOK, DM, 2048, 2048}; pg8::StaticOrder S; S.init(MTOK, DM, C.G, bx);
        pg8::Epi<FStore> E{{MIX1, DM}}; pg8::gemm_phase<false>(C.lds, C.wave, g, S, E); } SEAM(13);
    if (IN(14)) { p_norm(C, nullptr, HB, MIX1, in[2] + DM, HB, nullptr, RS, QUP1 ? (signed char*)(ws + 384 * MiB) : nullptr); } SEAM(14);
    if (IN(15)) { pg8::StaticOrder S; S.init(MTOK, FF, C.G, bx);
        if (QUP1) { pg8::Gemm g{(const bf16_t*)(ws + 384 * MiB), (const bf16_t*)(ws + W_UP1), MTOK, FF, DM / 2, DM / 2}; pg8::Epi<FRelu2> E{{(bf16_t*)(ws + 64 * MiB), FF, RS, (const float*)(ws + WS_SW) + 3 * 6144}}; pg8::gemm_phase<true>(C.lds, C.wave, g, S, E); }
        else { pg8::Gemm g{HB, (const bf16_t*)(ws + W_UP1), MTOK, FF, DM, DM}; pg8::Epi<FRelu2> E{{(bf16_t*)(ws + 64 * MiB), FF, RS, nullptr}}; pg8::gemm_phase<false>(C.lds, C.wave, g, S, E); } } SEAM(15);
    if (IN(16)) { pg8::Gemm g{(const bf16_t*)(ws + 64 * MiB), (const bf16_t*)(ws + W_DN1), MTOK, DM, FF, FF}; pg8::StaticOrder S; S.init(MTOK, DM, C.G, bx, 1);
        pg8::Epi<FStore> E{{(bf16_t*)(ws + 320 * MiB), DM}}; pg8::gemm_phase<false>(C.lds, C.wave, g, S, E); } SEAM(16);
    if (IN(17)) { p_norm(C, nullptr, HB, (const bf16_t*)(ws + 320 * MiB), in[4] + DM, nullptr, H, nullptr); }
#undef IN
#undef SEAM
}

extern "C" void kernel_launch(void* const* d_in, const int* in_sizes, int n_in, void* d_out, int out_size, void* d_ws, size_t ws_size, hipStream_t stream) {
    static int grid = 0;
    if (grid == 0) {
        if (n_in != 27 || out_size != MTOK * DM || ws_size < WS_END) { fprintf(stderr, "kernel_launch: unexpected shapes (n_in %d out %d ws %zu)\n", n_in, out_size, ws_size); grid = -1; return; }
        int dev = 0, cus = 0;
        if (hipGetDevice(&dev) != hipSuccess || hipDeviceGetAttribute(&cus, hipDeviceAttributeMultiprocessorCount, dev) != hipSuccess) { grid = -1; return; }
        if (hipFuncSetAttribute((const void*)fwd_kernel, hipFuncAttributeMaxDynamicSharedMemorySize, LDS_BYTES) != hipSuccess) { fprintf(stderr, "kernel_launch: hipFuncSetAttribute failed\n"); grid = -1; return; }
        int per_cu = 0;
        if (hipOccupancyMaxActiveBlocksPerMultiprocessor(&per_cu, (const void*)fwd_kernel, 512, LDS_BYTES) != hipSuccess || per_cu < 1) { fprintf(stderr, "kernel_launch: occupancy query says %d blocks per CU; nothing launched\n", per_cu); grid = -1; return; }
        (void)hipGetLastError();
        grid = cus;
    }
    if (grid < 0) return;
    (void)hipMemsetAsync((char*)d_ws + WS_CTL, 0, CTL_ZERO_BYTES, stream);
    Args a{};
    for (int i = 0; i < 27; ++i) a.in[i] = (const float*)d_in[i];
    a.out = (float*)d_out; a.ws = (unsigned char*)d_ws;
#if MK_PER_PHASE
    const int order[NPHASE] = {0, 1, 2, 3, 4, 18, 5, 6, 7, 8, 9, 10, 11, 12, 13, 14, 15, 16, 17};
    for (int q = 0; q < NPHASE; ++q) { const int p = order[q]; a.ph_lo = p; a.ph_hi = p + 1; hipLaunchKernelGGL(fwd_kernel, dim3(grid), dim3(512), LDS_BYTES, stream, a); }
#else
    a.ph_lo = 0; a.ph_hi = NPHASE; hipLaunchKernelGGL(fwd_kernel, dim3(grid), dim3(512), LDS_BYTES, stream, a);
#endif
}
```
